# Optimizing an MI355X kernel written in HIP

```python
import math
import jax, jax.numpy as jnp
from jax import lax
import numpy as np

D_MODEL = 1024
BATCH = 8
SEQ = 8192
DEPTH = 1

GRID_W = 64
EPS = 1e-6
ATTN_HEADS = 8
ATTN_KV_HEADS = 2
GQA_GROUP = ATTN_HEADS // ATTN_KV_HEADS
HEAD_DIM = 64
ROPE_THETA = 10000.0
ROPE_AXIS_DIM = HEAD_DIM // 2
Q_BLOCK = 128
HGRN_HEADS = 4
HGRN_DK = 128
HGRN_DV = 128
HGRN_CHUNK = 32
HGRN_SCALE = HGRN_DK ** -0.5
N_GROUPS = 4
EXPERTS_PER_GROUP = 8
N_EXPERTS = N_GROUPS * EXPERTS_PER_GROUP
TOP_K = 2
D_EXPERT = 512

ATTN_Q_W = ATTN_HEADS * HEAD_DIM
ATTN_KV_W = ATTN_KV_HEADS * HEAD_DIM
HGRN_K_W = HGRN_HEADS * HGRN_DK
HGRN_V_W = HGRN_HEADS * HGRN_DV
IN_SPLITS = (ATTN_Q_W, ATTN_KV_W, ATTN_KV_W, HGRN_K_W, HGRN_K_W, HGRN_K_W, HGRN_V_W, HGRN_V_W, D_MODEL, D_MODEL)
D_IN = sum(IN_SPLITS)
SPLIT_POINTS = tuple(int(s) for s in np.cumsum(IN_SPLITS)[:-1])

kernel_name = "hybrid_gqa_hgrn2_hiermoe_encoder"


def rmsnorm(x, g):
    xf = x.astype(jnp.float32)
    y = xf * lax.rsqrt(jnp.mean(xf * xf, axis=-1, keepdims=True) + EPS)
    return (y * g.astype(jnp.float32)).astype(x.dtype)


def axial_rope_tables(seq):
    rows = seq // GRID_W
    row_ids = jnp.repeat(jnp.arange(rows), GRID_W).astype(jnp.float32)
    col_ids = jnp.tile(jnp.arange(GRID_W), rows).astype(jnp.float32)
    inv_freq = ROPE_THETA ** (-jnp.arange(0, ROPE_AXIS_DIM, 2, dtype=jnp.float32) / ROPE_AXIS_DIM)
    ang = jnp.concatenate([row_ids[:, None] * inv_freq, col_ids[:, None] * inv_freq], axis=-1)
    return jnp.cos(ang), jnp.sin(ang)


def apply_rope(x, cos, sin):
    xr = x.astype(jnp.float32).reshape(x.shape[:-1] + (HEAD_DIM // 2, 2))
    a, b = xr[..., 0], xr[..., 1]
    out = jnp.stack([a * cos - b * sin, a * sin + b * cos], axis=-1)
    return out.reshape(x.shape).astype(x.dtype)


def bidir_gqa(q, k, v, q_norm, k_norm):
    B, S, _ = q.shape
    q = rmsnorm(q.reshape(B, S, ATTN_KV_HEADS, GQA_GROUP, HEAD_DIM), q_norm)
    k = rmsnorm(k.reshape(B, S, ATTN_KV_HEADS, HEAD_DIM), k_norm)
    v = v.reshape(B, S, ATTN_KV_HEADS, HEAD_DIM)
    cos, sin = axial_rope_tables(S)
    q = apply_rope(q, cos[:, None, None, :], sin[:, None, None, :])
    k = apply_rope(k, cos[:, None, :], sin[:, None, :])
    nb = S // Q_BLOCK
    qb = q.reshape(B, nb, Q_BLOCK, ATTN_KV_HEADS, GQA_GROUP, HEAD_DIM).transpose(1, 0, 3, 4, 2, 5)
    kt = k.transpose(0, 2, 1, 3)
    vt = v.transpose(0, 2, 1, 3)
    scale = HEAD_DIM ** -0.5

    def one_block(qblk):
        s = jnp.einsum('bhgqd,bhkd->bhgqk', qblk, kt).astype(jnp.float32) * scale
        p = jax.nn.softmax(s, axis=-1).astype(vt.dtype)
        return jnp.einsum('bhgqk,bhkd->bhgqd', p, vt)

    o = lax.map(one_block, qb)
    return o.transpose(1, 0, 4, 2, 3, 5).reshape(B, S, ATTN_Q_W)


def gla_chunkwise(q, k, v, log_f):
    B, H, S, dk = q.shape
    dv = v.shape[-1]
    nc = S // HGRN_CHUNK
    C = HGRN_CHUNK
    q = q.reshape(B, H, nc, C, dk)
    k = k.reshape(B, H, nc, C, dk)
    v = v.reshape(B, H, nc, C, dv)
    b = jnp.cumsum(log_f.reshape(B, H, nc, C, dk), axis=3)
    b_last = b[:, :, :, C - 1:, :]
    b_ref = b[:, :, :, C // 2:C // 2 + 1, :]
    a = jnp.einsum('bhnck,bhnsk->bhncs', q * jnp.exp(b - b_ref), k * jnp.exp(b_ref - b))
    mask = jnp.tril(jnp.ones((C, C), dtype=bool))
    o_intra = jnp.einsum('bhncs,bhnsv->bhncv', jnp.where(mask, a, 0.0), v)
    q_inter = q * jnp.exp(b)
    k_state = k * jnp.exp(b_last - b)
    decay = jnp.exp(b_last[:, :, :, 0, :])
    xs = (jnp.moveaxis(q_inter, 2, 0), jnp.moveaxis(k_state, 2, 0), jnp.moveaxis(v, 2, 0), jnp.moveaxis(decay, 2, 0))

    def step(state, inp):
        qi, ks, vv, d = inp
        o = jnp.einsum('bhck,bhkv->bhcv', qi, state)
        state = d[..., None] * state + jnp.einsum('bhck,bhcv->bhkv', ks, vv)
        return state, o

    s0 = jnp.zeros((B, H, dk, dv), jnp.float32)
    _, o_inter = lax.scan(step, s0, xs)
    o = o_intra + jnp.moveaxis(o_inter, 0, 2)
    return o.reshape(B, H, S, dv)


def hgrn2_bidir(hq, f_fwd, f_bwd, i_in, out_gate, lb_f, lb_b, hgrn_norm):
    B, S, _ = hq.shape

    def heads(t, d):
        return t.reshape(B, S, HGRN_HEADS, d).transpose(0, 2, 1, 3).astype(jnp.float32)

    q = heads(jax.nn.silu(hq.astype(jnp.float32)) * HGRN_SCALE, HGRN_DK)
    v = heads(i_in, HGRN_DV)

    def direction(f_logits, lb, flip):
        z = f_logits.astype(jnp.float32)
        f = lb + (1.0 - lb) * jax.nn.sigmoid(z)
        k = heads((1.0 - lb) * jax.nn.sigmoid(-z), HGRN_DK)
        log_f = heads(jnp.log(f), HGRN_DK)
        if flip:
            o = gla_chunkwise(jnp.flip(q, 2), jnp.flip(k, 2), jnp.flip(v, 2), jnp.flip(log_f, 2))
            return jnp.flip(o, 2)
        return gla_chunkwise(q, k, v, log_f)

    o = direction(f_fwd, lb_f, False) + direction(f_bwd, lb_b, True)
    o = rmsnorm(o.transpose(0, 2, 1, 3), hgrn_norm)
    o = o * jax.nn.silu(out_gate.reshape(B, S, HGRN_HEADS, HGRN_DV).astype(jnp.float32))
    return o.reshape(B, S, HGRN_V_W).astype(hq.dtype)


def hier_moe(h, w_rg, b_rg, w_re, b_re, w_gate, w_up, w_down):
    B, S, D = h.shape
    t = h.reshape(B * S, D)
    g_prob = jax.nn.softmax((t @ w_rg + b_rg).astype(jnp.float32), axis=-1)
    p_g, g_idx = lax.top_k(g_prob, 1)
    e_logits = (t @ w_re + b_re).astype(jnp.float32).reshape(-1, N_GROUPS, EXPERTS_PER_GROUP)
    e_sel = jnp.take_along_axis(e_logits, g_idx[:, :, None], axis=1)[:, 0]
    p_e, e_idx = lax.top_k(jax.nn.softmax(e_sel, axis=-1), TOP_K)
    p_e = p_e / jnp.sum(p_e, axis=-1, keepdims=True)
    expert_ids = g_idx * EXPERTS_PER_GROUP + e_idx
    combine = p_g * p_e
    dense_w = jnp.sum(jax.nn.one_hot(expert_ids, N_EXPERTS, dtype=jnp.float32) * combine[..., None], axis=1)
    dense_w = dense_w.astype(t.dtype)
    y = jnp.zeros((B * S, D), jnp.float32)
    for e in range(N_EXPERTS):
        hid = jax.nn.silu(t @ w_gate[e]) * (t @ w_up[e])
        y = y + ((hid * dense_w[:, e:e + 1]) @ w_down[e]).astype(jnp.float32)
    return y.reshape(B, S, D).astype(h.dtype)


def setup_inputs(seed: int = 0) -> dict:
    key = jax.random.key(seed)
    ks = jax.random.split(key, 20)
    f32 = jnp.float32
    L = DEPTH

    def nrm(k, shape, scale):
        return jax.random.normal(k, shape, f32) * scale

    return {
        "x": nrm(ks[0], (BATCH, SEQ, D_MODEL), 1.0),
        "g_mix": 1.0 + nrm(ks[1], (L, D_MODEL), 0.02),
        "w_in": nrm(ks[2], (L, D_MODEL, D_IN), D_MODEL ** -0.5),
        "q_norm": 1.0 + nrm(ks[3], (L, HEAD_DIM), 0.02),
        "k_norm": 1.0 + nrm(ks[4], (L, HEAD_DIM), 0.02),
        "hgrn_norm": 1.0 + nrm(ks[5], (L, HGRN_DV), 0.02),
        "lb_fwd": nrm(ks[6], (L + 1, HGRN_K_W), 0.5),
        "lb_bwd": nrm(ks[7], (L + 1, HGRN_K_W), 0.5),
        "w_attn_branch": nrm(ks[8], (L, ATTN_Q_W, D_MODEL), ATTN_Q_W ** -0.5),
        "w_hgrn_branch": nrm(ks[9], (L, HGRN_V_W, D_MODEL), HGRN_V_W ** -0.5),
        "w_out": nrm(ks[10], (L, D_MODEL, D_MODEL), D_MODEL ** -0.5),
        "g_ffn": 1.0 + nrm(ks[11], (L, D_MODEL), 0.02),
        "w_router_group": nrm(ks[12], (L, D_MODEL, N_GROUPS), D_MODEL ** -0.5),
        "b_router_group": nrm(ks[13], (L, N_GROUPS), 0.01),
        "w_router_expert": nrm(ks[14], (L, D_MODEL, N_EXPERTS), D_MODEL ** -0.5),
        "b_router_expert": nrm(ks[15], (L, N_EXPERTS), 0.01),
        "w_exp_gate": nrm(ks[16], (L, N_EXPERTS, D_MODEL, D_EXPERT), D_MODEL ** -0.5),
        "w_exp_up": nrm(ks[17], (L, N_EXPERTS, D_MODEL, D_EXPERT), D_MODEL ** -0.5),
        "w_exp_down": nrm(ks[18], (L, N_EXPERTS, D_EXPERT, D_MODEL), D_EXPERT ** -0.5),
    }


def reference(x, g_mix, w_in, q_norm, k_norm, hgrn_norm, lb_fwd, lb_bwd, w_attn_branch, w_hgrn_branch,
              w_out, g_ffn, w_router_group, b_router_group, w_router_expert, b_router_expert,
              w_exp_gate, w_exp_up, w_exp_down):
    lbs_f = jnp.cumsum(jax.nn.softmax(lb_fwd.astype(jnp.float32), axis=0), axis=0)
    lbs_b = jnp.cumsum(jax.nn.softmax(lb_bwd.astype(jnp.float32), axis=0), axis=0)
    for l in range(DEPTH):
        h = rmsnorm(x, g_mix[l])
        proj = h @ w_in[l]
        aq, ak, av, hq, hf_f, hf_b, hi, hg, gate_a, gate_b = jnp.split(proj, SPLIT_POINTS, axis=-1)
        attn_o = bidir_gqa(aq, ak, av, q_norm[l], k_norm[l])
        hgrn_o = hgrn2_bidir(hq, hf_f, hf_b, hi, hg, lbs_f[l], lbs_b[l], hgrn_norm[l])
        merged = (jax.nn.sigmoid(gate_a) * (attn_o @ w_attn_branch[l])
                  + jax.nn.sigmoid(gate_b) * (hgrn_o @ w_hgrn_branch[l]))
        x = x + merged @ w_out[l]
        h = rmsnorm(x, g_ffn[l])
        x = x + hier_moe(h, w_router_group[l], b_router_group[l], w_router_expert[l], b_router_expert[l],
                         w_exp_gate[l], w_exp_up[l], w_exp_down[l])
    return x
```

```cpp
#include <hip/hip_runtime.h>
#include <hip/hip_bf16.h>
#include <cstdio>
#include <cstdint>
#include <cmath>

#define LAS __attribute__((address_space(3)))
#define GAS __attribute__((address_space(1)))
typedef unsigned short bf16_t;
typedef short bf16x8 __attribute__((ext_vector_type(8)));
typedef short s16x4 __attribute__((ext_vector_type(4)));
typedef float f32x4 __attribute__((ext_vector_type(4)));
typedef float f32x2 __attribute__((ext_vector_type(2)));
typedef float f32x16 __attribute__((ext_vector_type(16)));
typedef unsigned u32x4 __attribute__((ext_vector_type(4)));
typedef int i32x4 __attribute__((ext_vector_type(4)));
typedef unsigned u32x2 __attribute__((ext_vector_type(2)));
typedef __bf16 bf16x2_t __attribute__((ext_vector_type(2)));

__device__ __forceinline__ int mk_lane() { int l; asm volatile("v_mbcnt_lo_u32_b32 %0, -1, 0\n\tv_mbcnt_hi_u32_b32 %0, -1, %0" : "=v"(l)); return l; }
__device__ __forceinline__ unsigned cvtpk(float lo, float hi) { f32x2 v = {lo, hi}; bf16x2_t b = __builtin_convertvector(v, bf16x2_t); return __builtin_bit_cast(unsigned, b); }
__device__ __forceinline__ float bf_lo(unsigned w) { return __uint_as_float(w << 16); }
__device__ __forceinline__ float bf_hi(unsigned w) { return __uint_as_float(w & 0xffff0000u); }
__device__ __forceinline__ float fast_exp(float x) { return __builtin_amdgcn_exp2f(x * 1.4426950408889634f); }
__device__ __forceinline__ float fast_rcp(float x) { return __builtin_amdgcn_rcpf(x); }
__device__ __forceinline__ float sigmoidf_(float x) { return fast_rcp(1.0f + fast_exp(-x)); }
__device__ __forceinline__ float siluf_(float x) { return x * sigmoidf_(x); }

namespace pg8 {
constexpr int BM = 256, BK = 64, HALF = 128, HTB = HALF * BK * 2, STAGE_BYTES = 8 * HTB, NXCD = 8, WGM = 8;
__host__ __device__ __forceinline__ int lds_byte(int r, int c) { const int st = (r >> 4) * 2 + (c >> 5), rr = r & 15, cc = c & 31, ob = rr * 64 + cc * 2; return st * 1024 + (ob ^ (((ob >> 9) & 1) << 5)); }
__host__ __device__ __forceinline__ void stage_rc(int b, int& R, int& C) { const int st = b / 1024, sb = b % 1024, swz = sb ^ (((sb >> 9) & 1) << 5); R = (st >> 1) * 16 + swz / 64; C = (st & 1) * 32 + (swz % 64) / 2; }
__host__ __device__ __forceinline__ int perm32(int rho) { const int n = rho >> 4, i = rho & 15; return 8 * (i >> 2) + 4 * n + (i & 3); }

struct GUnit { int pm, pn; const char* Ab; const char* Bb; int seg; int aux; };

struct TileOrder {
    int nM, nN, nwg, G, c;
    __device__ void init(int nM_, int nN_, int G_, int c_) { nM = nM_; nN = nN_; nwg = nM * nN; G = G_; c = c_; }
    __device__ bool tile(int i, int& pm, int& pn) const {
        const long L = (long)i * G + c; if (L >= nwg) return false;
        int wgid = (int)L; { const int q = nwg / NXCD, r = nwg % NXCD, xcd = wgid % NXCD, off = wgid / NXCD; wgid = (xcd < r ? xcd * (q + 1) : r * (q + 1) + (xcd - r) * q) + off; }
        const int nig = WGM * nN, gid = wgid / nig, fm = gid * WGM, gsz = (nM - fm) < WGM ? (nM - fm) : WGM;
        pm = fm + ((wgid % nig) % gsz); pn = (wgid % nig) / gsz; return true;
    }
};

template <class Epi, class Sched, bool ALIGN_EPI, bool I8 = false>
__device__ __forceinline__ void gemm_phase(LAS unsigned char* lds, const int wave, const int K, const Sched& S, const Epi& E) {
    int tid_ = wave * 64 + mk_lane(); asm volatile("" : "+v"(tid_));
    const int tid = tid_, wid = __builtin_amdgcn_readfirstlane(tid >> 6), lane = tid & 63, wr = wid >> 2, wc = wid & 3, fr = lane & 15, fq = lane >> 4;
    const int nt = K / BK;
    int Rr[2], Cc[2]; unsigned voffB[2];
#pragma unroll
    for (int i = 0; i < 2; ++i) { int R, C; stage_rc(tid * 16 + i * 8192, R, C); Rr[i] = R; Cc[i] = C; const int Rb = (R & ~31) + perm32(R & 31); voffB[i] = (unsigned)(Rb * K + C) * 2u; }
    const unsigned kstep = (unsigned)(BK * 2);
    const size_t hstepB = (size_t)HALF * K * 2;
    const unsigned ldsw = (unsigned)wid * 1024u;
    const int aoff = lds_byte(wr * 64 + fr, fq * 8), boff = lds_byte(wc * 32 + fr, fq * 8);
#define PG8_SA(b, h) (((b) * 2 + (h)) * HTB)
#define PG8_SB(b, h) ((4 + (b) * 2 + (h)) * HTB)
#define PG8_STAGE_B(bufoff, gbase) do { _Pragma("unroll") for (int _i = 0; _i < 2; ++_i) \
        __builtin_amdgcn_global_load_lds((const unsigned*)((const char*)(gbase) + voffB[_i]), (LAS unsigned*)(lds + (bufoff) + ldsw + _i * 8192), 16, 0, 0); } while (0)
#define PG8_STAGE_A(bufoff, gbase, o0, o1) do { \
        __builtin_amdgcn_global_load_lds((const unsigned*)((const char*)(gbase) + (o0)), (LAS unsigned*)(lds + (bufoff) + ldsw), 16, 0, 0); \
        __builtin_amdgcn_global_load_lds((const unsigned*)((const char*)(gbase) + (o1)), (LAS unsigned*)(lds + (bufoff) + ldsw + 8192), 16, 0, 0); } while (0)
#define PG8_LDA(dst, b, h) do { _Pragma("unroll") for (int m = 0; m < 4; ++m) _Pragma("unroll") for (int k = 0; k < 2; ++k) dst[m][k] = *(const LAS bf16x8*)(lds + PG8_SA(b, h) + aoff + m * 2048 + k * 1024); } while (0)
#define PG8_LDB(dst, b, h) do { _Pragma("unroll") for (int n = 0; n < 2; ++n) _Pragma("unroll") for (int k = 0; k < 2; ++k) dst[n][k] = *(const LAS bf16x8*)(lds + PG8_SB(b, h) + boff + n * 2048 + k * 1024); } while (0)
#define PG8_MMA(ai, bj, At, Bt) do { __builtin_amdgcn_s_setprio(1); _Pragma("unroll") for (int m = 0; m < 4; ++m) _Pragma("unroll") for (int n = 0; n < 2; ++n) _Pragma("unroll") for (int k = 0; k < 2; ++k) { \
        if constexpr (I8) acc[ai][bj][m][n] = __builtin_bit_cast(f32x4, __builtin_amdgcn_mfma_i32_16x16x64_i8(__builtin_bit_cast(i32x4, Bt[n][k]), __builtin_bit_cast(i32x4, At[m][k]), __builtin_bit_cast(i32x4, acc[ai][bj][m][n]), 0, 0, 0)); \
        else acc[ai][bj][m][n] = __builtin_amdgcn_mfma_f32_16x16x32_bf16(Bt[n][k], At[m][k], acc[ai][bj][m][n], 0, 0, 0); } __builtin_amdgcn_s_setprio(0); } while (0)
#define PG8_WAIT_V(n) asm volatile("s_waitcnt vmcnt(" #n ")" ::: "memory")
#define PG8_WAIT_L(n) asm volatile("s_waitcnt lgkmcnt(" #n ")" ::: "memory")
#define PG8_BAR __builtin_amdgcn_s_barrier()
#define PG8_SCHED __builtin_amdgcn_sched_barrier(0)
    GUnit cur, nxt; int ui = 0;
    if (!S.next(0, cur)) return;
    unsigned ca[2][2], na[2][2];
    S.aoff(cur, Rr, Cc, ca);
    f32x4 acc[2][2][4][2];
#pragma unroll
    for (int a = 0; a < 2; ++a)
#pragma unroll
        for (int b = 0; b < 2; ++b)
#pragma unroll
            for (int m = 0; m < 4; ++m)
#pragma unroll
                for (int n = 0; n < 2; ++n) acc[a][b][m][n] = (f32x4){0.f, 0.f, 0.f, 0.f};
    bf16x8 At[4][2], B0[2][2], B1[2][2];
    const char* cA = cur.Ab; const char* cB = cur.Bb;
    PG8_STAGE_B(PG8_SB(0, 0), cB); PG8_STAGE_B(PG8_SB(0, 1), cB + hstepB); PG8_STAGE_A(PG8_SA(0, 0), cA, ca[0][0], ca[0][1]); PG8_STAGE_A(PG8_SA(0, 1), cA, ca[1][0], ca[1][1]);
    if (wr == 1) PG8_BAR;
    PG8_WAIT_V(2); PG8_BAR;
    PG8_STAGE_B(PG8_SB(1, 0), cB + kstep); PG8_STAGE_A(PG8_SA(1, 0), cA + kstep, ca[0][0], ca[0][1]); PG8_STAGE_B(PG8_SB(1, 1), cB + hstepB + kstep);
    PG8_WAIT_V(6); PG8_BAR;
    for (;;) {
        const bool has_next = S.next(ui + 1, nxt);
        if (has_next) S.aoff_raw(nxt, Rr, Cc, na);
        else {
#pragma unroll
            for (int h = 0; h < 2; ++h)
#pragma unroll
                for (int i = 0; i < 2; ++i) na[h][i] = ca[h][i];
        }
        const char* nA = has_next ? nxt.Ab : cA; const char* nB = has_next ? nxt.Bb : cB;
        for (int t = 0; t < nt; t += 2) {
            const bool last = (t == nt - 2);
            const char* a1 = cA + (size_t)(t + 1) * kstep;
            const char* a2 = last ? nA : cA + (size_t)(t + 2) * kstep; const char* b2 = last ? nB : cB + (size_t)(t + 2) * kstep;
            const char* a3 = a2 + kstep; const char* b3 = b2 + kstep;
            unsigned o00 = ca[0][0], o01 = ca[0][1], o10 = ca[1][0], o11 = ca[1][1];
            if (last) { if (has_next) S.aoff_fin(nxt, na, Cc); asm volatile("" : "+v"(na[0][0]), "+v"(na[0][1]), "+v"(na[1][0]), "+v"(na[1][1]));
                o00 = na[0][0]; o01 = na[0][1]; o10 = na[1][0]; o11 = na[1][1]; }
            PG8_LDB(B0, 0, 0); PG8_LDB(B1, 0, 1); PG8_SCHED; PG8_LDA(At, 0, 0); PG8_STAGE_A(PG8_SA(1, 1), a1, ca[1][0], ca[1][1]);
            PG8_WAIT_V(8); PG8_WAIT_L(0); PG8_BAR; PG8_MMA(0, 0, At, B0); PG8_MMA(0, 1, At, B1); PG8_BAR; PG8_SCHED;
            PG8_LDA(At, 0, 1); PG8_STAGE_B(PG8_SB(0, 0), b2); PG8_STAGE_B(PG8_SB(0, 1), b2 + hstepB); PG8_STAGE_A(PG8_SA(0, 0), a2, o00, o01);
            PG8_WAIT_V(8); PG8_WAIT_L(0); PG8_BAR; PG8_MMA(1, 0, At, B0); PG8_MMA(1, 1, At, B1); PG8_BAR; PG8_SCHED;
            PG8_LDB(B0, 1, 0); PG8_LDB(B1, 1, 1); PG8_SCHED; PG8_LDA(At, 1, 0); PG8_STAGE_A(PG8_SA(0, 1), a2, o10, o11);
            PG8_WAIT_V(8); PG8_WAIT_L(0); PG8_BAR; PG8_MMA(0, 0, At, B0); PG8_MMA(0, 1, At, B1); PG8_BAR; PG8_SCHED;
            PG8_LDA(At, 1, 1); PG8_STAGE_B(PG8_SB(1, 0), b3); PG8_STAGE_B(PG8_SB(1, 1), b3 + hstepB); PG8_STAGE_A(PG8_SA(1, 0), a3, o00, o01);
            PG8_WAIT_V(8); PG8_WAIT_L(0); PG8_BAR; PG8_MMA(1, 0, At, B0); PG8_MMA(1, 1, At, B1); PG8_BAR; PG8_SCHED;
        }
        if constexpr (ALIGN_EPI) { if (wr == 0) PG8_BAR; }
        bool keep = false;
        if constexpr (Epi::SEG2) keep = (cur.seg == 0);
        if (keep) E.mid(acc, cur, wr, wc, fr, fq); else E(acc, cur, wr, wc, fr, fq);
        if (!has_next) break;
        if (!keep) {
#pragma unroll
            for (int a = 0; a < 2; ++a)
#pragma unroll
                for (int b = 0; b < 2; ++b)
#pragma unroll
                    for (int m = 0; m < 4; ++m)
#pragma unroll
                        for (int n = 0; n < 2; ++n) acc[a][b][m][n] = (f32x4){0.f, 0.f, 0.f, 0.f};
        }
        cur = nxt; cA = nA; cB = nB; ++ui;
#pragma unroll
        for (int h = 0; h < 2; ++h)
#pragma unroll
            for (int i = 0; i < 2; ++i) ca[h][i] = na[h][i];
        if constexpr (ALIGN_EPI) { if (wr == 1) PG8_BAR; }
    }
    PG8_WAIT_V(0);
    if constexpr (!ALIGN_EPI) { if (wr == 0) PG8_BAR; }
    PG8_BAR;
#undef PG8_SA
#undef PG8_SB
#undef PG8_STAGE_A
#undef PG8_STAGE_B
#undef PG8_LDA
#undef PG8_LDB
#undef PG8_MMA
#undef PG8_WAIT_V
#undef PG8_WAIT_L
#undef PG8_BAR
#undef PG8_SCHED
}
}
namespace attn_body {
using bf16=__hip_bfloat16;
constexpr int BATCH=8,NHEAD=8,NKVH=2,SEQ=8192,D=64,QP=NHEAD*D,KP=NKVH*D;
constexpr int NW=8,QBLK=32,QB=QBLK*NW,KVBLK=64,NQB=SEQ/QB;
constexpr int ATTN_UNIT_ROWS=QB;
__device__ __forceinline__ int crow(int r,int hi){return (r&3)+8*(r>>2)+4*hi;}
#define SBAR() __builtin_amdgcn_sched_barrier(0)
constexpr int NSLOT=3, SLOTB=8192;
constexpr int LDS_K=0, LDS_V=NSLOT*SLOTB, LDS_WS=2*NSLOT*SLOTB, LDS_OST=LDS_WS+NW*64*4, LDS_BYTES=LDS_OST+NW*4096;
constexpr float C2=0.125f*1.4426950408889634f;
__device__ __forceinline__ void glds16(const void*gsrc,unsigned lds_dst){unsigned keep;
  asm volatile("s_mov_b32 %0, m0\n\ts_mov_b32 m0, %2\n\ts_nop 0\n\tglobal_load_lds_dwordx4 %1, off\n\ts_mov_b32 m0, %0":"=&s"(keep):"v"(gsrc),"s"(lds_dst):"memory");}
typedef float f32x2_t __attribute__((ext_vector_type(2))); typedef __bf16 bf16x2_t __attribute__((ext_vector_type(2)));
__device__ __forceinline__ unsigned cvtpk_s(float lo,float hi){f32x2_t v={lo,hi};bf16x2_t b=__builtin_convertvector(v,bf16x2_t);return __builtin_bit_cast(unsigned,b);}
#define WAIT_BAR(N) asm volatile("s_waitcnt vmcnt(" #N ") lgkmcnt(0)\n\ts_barrier":::"memory")

__device__ __forceinline__ void qkt(f32x16&p0,f32x16&p1,const char*Kslot,const bf16x8*qr,const f32x16&negm,int r32,int hi){
  const char*kb=Kslot+hi*1024+r32*16;
  #pragma unroll
  for(int d0=0;d0<4;++d0){
    const bf16x8 b0=*reinterpret_cast<const bf16x8*>(kb+d0*2048);
    const bf16x8 b1=*reinterpret_cast<const bf16x8*>(kb+d0*2048+512);
    if(d0==0){p0=__builtin_amdgcn_mfma_f32_32x32x16_bf16(b0,qr[0],negm,0,0,0);p1=__builtin_amdgcn_mfma_f32_32x32x16_bf16(b1,qr[0],negm,0,0,0);}
    else{p0=__builtin_amdgcn_mfma_f32_32x32x16_bf16(b0,qr[d0],p0,0,0,0);p1=__builtin_amdgcn_mfma_f32_32x32x16_bf16(b1,qr[d0],p1,0,0,0);}}
}
typedef __attribute__((address_space(3))) const char* lds_cptr;
typedef short v4i16_t __attribute__((ext_vector_type(4)));
__device__ __forceinline__ void kload8(bf16x8*kf,lds_cptr kp){
  kf[0]=*(const __attribute__((address_space(3))) bf16x8*)(kp);      kf[1]=*(const __attribute__((address_space(3))) bf16x8*)(kp+512);
  kf[2]=*(const __attribute__((address_space(3))) bf16x8*)(kp+2048); kf[3]=*(const __attribute__((address_space(3))) bf16x8*)(kp+2560);
  kf[4]=*(const __attribute__((address_space(3))) bf16x8*)(kp+4096); kf[5]=*(const __attribute__((address_space(3))) bf16x8*)(kp+4608);
  kf[6]=*(const __attribute__((address_space(3))) bf16x8*)(kp+6144); kf[7]=*(const __attribute__((address_space(3))) bf16x8*)(kp+6656);
}
__device__ __forceinline__ void kload2(bf16x8*kf,lds_cptr kp,int j){ kf[2*j]=*(const __attribute__((address_space(3))) bf16x8*)(kp+j*2048); kf[2*j+1]=*(const __attribute__((address_space(3))) bf16x8*)(kp+j*2048+512); }
__device__ __forceinline__ s16x4 vtr(lds_cptr p){ return __builtin_bit_cast(s16x4,__builtin_amdgcn_ds_read_tr16_b64_v4i16((__attribute__((address_space(3))) v4i16_t*)p)); }
__device__ __forceinline__ void pv(f32x16*o,int vb,bf16x8 pa0,bf16x8 pa1,bf16x8 pa2,bf16x8 pa3){
  #pragma unroll
  for(int d0=0;d0<2;++d0){s16x4 lo[4],hi[4];
    #pragma unroll
    for(int ks=0;ks<4;++ks){
      asm volatile("ds_read_b64_tr_b16 %0,%1 offset:%c2":"=&v"(lo[ks]):"v"(vb),"i"(d0*4096+ks*1024):"memory");
      asm volatile("ds_read_b64_tr_b16 %0,%1 offset:%c2":"=&v"(hi[ks]):"v"(vb),"i"(d0*4096+ks*1024+512):"memory");}
    asm volatile("s_waitcnt lgkmcnt(0)":::"memory");SBAR();
    #define PK(k) (bf16x8){lo[k][0],lo[k][1],lo[k][2],lo[k][3],hi[k][0],hi[k][1],hi[k][2],hi[k][3]}
    o[d0]=__builtin_amdgcn_mfma_f32_32x32x16_bf16(pa0,PK(0),o[d0],0,0,0);
    o[d0]=__builtin_amdgcn_mfma_f32_32x32x16_bf16(pa1,PK(1),o[d0],0,0,0);
    o[d0]=__builtin_amdgcn_mfma_f32_32x32x16_bf16(pa2,PK(2),o[d0],0,0,0);
    o[d0]=__builtin_amdgcn_mfma_f32_32x32x16_bf16(pa3,PK(3),o[d0],0,0,0);
    #undef PK
  }
}

#ifndef ATTN_STORE16
#define ATTN_STORE16(p,v) (*(u32x4*)(p)=(v))
#endif
__device__ __forceinline__ void attn_unit(int b,int h,int qb,const bf16*Q,const bf16*__restrict__ K,const bf16*__restrict__ V,bf16*O,char*shm,float mbound,int wave){
  int tid_=wave*64+mk_lane(); asm volatile("":"+v"(tid_)); const int tid=tid_,lane=tid&63,r32=lane&31,hi=lane>>5; const int wid=__builtin_amdgcn_readfirstlane(tid>>6);
  const long rowbase=(long)b*SEQ; const int q0=qb*QB;
  const bf16*Qw=Q+(rowbase+q0+wid*QBLK)*QP+h*D;
  const bf16*Kh=K+rowbase*KP+(h>>2)*D,*Vh=V+rowbase*KP+(h>>2)*D;
  const unsigned lds0=(unsigned)(uintptr_t)shm;
  float*wsf=(float*)(shm+LDS_WS)+wid*64;
  const bf16*ksrc=Kh+(long)lane*KP+wid*8;
  const bf16*vsrc=Vh+(long)(16*(wid&3)+(lane>>2))*KP+(wid>>2)*32+(lane&3)*8;
  const unsigned kdst=lds0+LDS_K+wid*1024, vdst=lds0+LDS_V+wid*1024;
  #define DMA_K(t,slot) glds16(ksrc+(long)(t)*KVBLK*KP,(unsigned)__builtin_amdgcn_readfirstlane(kdst+(slot)))
  #define DMA_V(t,slot) glds16(vsrc+(long)(t)*KVBLK*KP,(unsigned)__builtin_amdgcn_readfirstlane(vdst+(slot)))
  const int vb0=(int)(lds0+LDS_V)+((lane>>4)&1)*32+(lane&3)*8+(4*hi+((lane&15)>>2))*64;
  const char*Kbase=shm+LDS_K; bf16x8 kf[8];
  const lds_cptr shm3=(lds_cptr)shm; const lds_cptr kp0=shm3+LDS_K+hi*1024+r32*16; const lds_cptr vp0=shm3+LDS_V+((lane>>4)&1)*32+(lane&3)*8+(4*hi+((lane&15)>>2))*64;
  constexpr int NT=SEQ/KVBLK;
  DMA_K(0,0);DMA_V(0,0);DMA_K(1,SLOTB);
  bf16x8 qr[4];
  #pragma unroll
  for(int d0=0;d0<4;++d0)qr[d0]=*reinterpret_cast<const bf16x8*>(&Qw[(long)r32*QP+d0*16+hi*8]);
  float l_reg=0.f;f32x16 o[2];o[0]=f32x16{};o[1]=f32x16{};f32x16 negm;
  _Pragma("unroll") for(int r=0;r<16;++r)negm[r]=-mbound; asm volatile("":"+v"(negm));
  #define START(P0,P1) do{ _Pragma("unroll") for(int r=0;r<16;++r)P0[r]=__builtin_amdgcn_exp2f(P0[r]); }while(0)
  #define RESC() do{}while(0)
  f32x16 pA0,pA1,pB0,pB1;
  int sl_prev=0,sl_cur=0,sl_next=SLOTB;
  #define ROT() do{sl_prev=sl_cur;sl_cur=sl_next;sl_next=(sl_next==(NSLOT-1)*SLOTB)?0:sl_next+SLOTB;}while(0)
  DMA_K(2,2*SLOTB);
  WAIT_BAR(3);
  qkt(pA0,pA1,Kbase,qr,negm,r32,hi);asm volatile("s_nop 15\n\ts_nop 7":"+v"(pA0),"+v"(pA1));
  START(pA0,pA1);
  _Pragma("unroll") for(int r=0;r<16;++r)pA1[r]=__builtin_amdgcn_exp2f(pA1[r]);
  WAIT_BAR(0);
  DMA_K(3,0);DMA_V(1,SLOTB);
  ROT();
  kload8(kf,kp0+sl_cur);
  WAIT_BAR(2);
  s16x4 vlo[8],vhi[8]; u32x4 pw0,pw1,pw2,pw3;
  #define PKW(P,B) cvtpk_s(P[B],P[B+1])
  #define PAF(k) __builtin_bit_cast(bf16x8,pw##k)
  #define VFR(i) (bf16x8){vlo[i][0],vlo[i][1],vlo[i][2],vlo[i][3],vhi[i][0],vhi[i][1],vhi[i][2],vhi[i][3]}
  #define PIN(x) asm volatile("":"+v"(x))
  #define MX3(a,b,c) __builtin_fmaxf(__builtin_fmaxf((a),(b)),(c))
  #define GAPA(MF,A0,A1,A2,A3,W0,W1,PW) do{ MF; sacc+=A0; sacc+=A1; sacc+=A2; sacc+=A3; PIN(sacc); W0; W1; PIN(PW); SBAR(); }while(0)
  #define EX(v) __builtin_amdgcn_exp2f(v)
  #define GAPB(MF,X,B) do{ MF; X[B]=EX(X[B]); X[B+1]=EX(X[B+1]); X[B+2]=EX(X[B+2]); X[B+3]=EX(X[B+3]); PIN(X); SBAR(); }while(0)
  #define VRD(i) do{ vlo[i]=vtr(vp_+(((i)>>2)*4096+((i)&3)*1024)); vhi[i]=vtr(vp_+(((i)>>2)*4096+((i)&3)*1024+512)); }while(0)
  #define KRD(G,j) do{ if(G){ kload2(kf,kp0+sl_next,j); SBAR(); } }while(0)
  #define STEP(C0,C1,P0,P1,t,GK,GV,GL) do{ SBAR(); \
    const lds_cptr vp_=vp0+sl_prev; \
    VRD(0); SBAR(); float sacc=(P0[0]+P0[1]); \
    GAPA(C0=__builtin_amdgcn_mfma_f32_32x32x16_bf16(kf[0],qr[0],negm,0,0,0), P0[2],P0[3],P0[4],P0[5],     pw0[0]=PKW(P0,0), pw0[1]=PKW(P0,2), pw0); \
    VRD(4); SBAR(); GAPA(C1=__builtin_amdgcn_mfma_f32_32x32x16_bf16(kf[1],qr[0],negm,0,0,0), P0[6],P0[7],P0[8],P0[9],     pw0[2]=PKW(P0,4), pw0[3]=PKW(P0,6), pw0); \
    VRD(1); SBAR(); GAPA(C0=__builtin_amdgcn_mfma_f32_32x32x16_bf16(kf[2],qr[1],C0,0,0,0),   P0[10],P0[11],P0[12],P0[13], pw1[0]=PKW(P0,8), pw1[1]=PKW(P0,10), pw1); \
    VRD(5); SBAR(); GAPA(C1=__builtin_amdgcn_mfma_f32_32x32x16_bf16(kf[3],qr[1],C1,0,0,0),   P0[14],P0[15],P1[0],P1[1],   pw1[2]=PKW(P0,12),pw1[3]=PKW(P0,14), pw1); \
    VRD(2); SBAR(); GAPA(C0=__builtin_amdgcn_mfma_f32_32x32x16_bf16(kf[4],qr[2],C0,0,0,0),   P1[2],P1[3],P1[4],P1[5],     pw2[0]=PKW(P1,0), pw2[1]=PKW(P1,2), pw2); \
    VRD(6); SBAR(); GAPA(C1=__builtin_amdgcn_mfma_f32_32x32x16_bf16(kf[5],qr[2],C1,0,0,0),   P1[6],P1[7],P1[8],P1[9],     pw2[2]=PKW(P1,4), pw2[3]=PKW(P1,6), pw2); \
    VRD(3); SBAR(); GAPA(C0=__builtin_amdgcn_mfma_f32_32x32x16_bf16(kf[6],qr[3],C0,0,0,0),   P1[10],P1[11],P1[12],P1[13], pw3[0]=PKW(P1,8), pw3[1]=PKW(P1,10), pw3); \
    VRD(7); SBAR(); GAPA(C1=__builtin_amdgcn_mfma_f32_32x32x16_bf16(kf[7],qr[3],C1,0,0,0),   P1[14],P1[15],0.f,0.f,       pw3[2]=PKW(P1,12),pw3[3]=PKW(P1,14), pw3); \
    l_reg+=sacc; \
    if(GK){DMA_K((t)+3,sl_cur);} if(GV){DMA_V((t)+1,sl_next);} \
    SBAR(); \
    GAPB(o[0]=__builtin_amdgcn_mfma_f32_32x32x16_bf16(PAF(0),VFR(0),o[0],0,0,0), C0,0); \
    GAPB(o[1]=__builtin_amdgcn_mfma_f32_32x32x16_bf16(PAF(0),VFR(4),o[1],0,0,0), C0,4); \
    KRD(GL,0); GAPB(o[0]=__builtin_amdgcn_mfma_f32_32x32x16_bf16(PAF(1),VFR(1),o[0],0,0,0), C0,8); \
    KRD(GL,1); GAPB(o[1]=__builtin_amdgcn_mfma_f32_32x32x16_bf16(PAF(1),VFR(5),o[1],0,0,0), C0,12); \
    KRD(GL,2); GAPB(o[0]=__builtin_amdgcn_mfma_f32_32x32x16_bf16(PAF(2),VFR(2),o[0],0,0,0), C1,0); \
    KRD(GL,3); GAPB(o[1]=__builtin_amdgcn_mfma_f32_32x32x16_bf16(PAF(2),VFR(6),o[1],0,0,0), C1,4); \
    GAPB(o[0]=__builtin_amdgcn_mfma_f32_32x32x16_bf16(PAF(3),VFR(3),o[0],0,0,0), C1,8); \
    GAPB(o[1]=__builtin_amdgcn_mfma_f32_32x32x16_bf16(PAF(3),VFR(7),o[1],0,0,0), C1,12); \
    }while(0)
  int t=1;
  for(;t+5<NT;t+=2){
    STEP(pB0,pB1,pA0,pA1,t,true,true,true);     WAIT_BAR(2); RESC(); ROT();
    STEP(pA0,pA1,pB0,pB1,t+1,true,true,true);   WAIT_BAR(2); RESC(); ROT();
  }
  #define ENDW(tt) do{ if((tt)+3<NT){WAIT_BAR(2);} else if((tt)+2<NT){WAIT_BAR(1);} else {WAIT_BAR(0);} }while(0)
  for(;t+1<NT;t+=2){
    STEP(pB0,pB1,pA0,pA1,t,(t+3<NT),(t+1<NT),(t+1<NT));       ENDW(t);   RESC(); ROT();
    STEP(pA0,pA1,pB0,pB1,t+1,(t+4<NT),(t+2<NT),(t+2<NT));     ENDW(t+1); RESC(); ROT();
  }
  STEP(pB0,pB1,pA0,pA1,NT-1,false,false,false); RESC();
  { float sacc=pB0[0]+pB0[1]; _Pragma("unroll") for(int r=2;r<16;++r)sacc+=pB0[r]; _Pragma("unroll") for(int r=0;r<16;++r)sacc+=pB1[r]; l_reg+=sacc;
    pw0=(u32x4){PKW(pB0,0),PKW(pB0,2),PKW(pB0,4),PKW(pB0,6)};pw1=(u32x4){PKW(pB0,8),PKW(pB0,10),PKW(pB0,12),PKW(pB0,14)};pw2=(u32x4){PKW(pB1,0),PKW(pB1,2),PKW(pB1,4),PKW(pB1,6)};pw3=(u32x4){PKW(pB1,8),PKW(pB1,10),PKW(pB1,12),PKW(pB1,14)};
    SBAR(); pv(o,vb0+sl_cur,PAF(0),PAF(1),PAF(2),PAF(3)); }
  #undef PKW
  #undef PAF
  #undef VFR
  #undef PIN
  #undef MX3
  #undef GAPA
  #undef GAPB
  #undef EX
  #undef VRD
  #undef KRD
  #undef STEP
  #undef ENDW
  {auto rr=__builtin_amdgcn_permlane32_swap(__float_as_uint(l_reg),__float_as_uint(l_reg),false,false);l_reg=__uint_as_float(rr[0])+__uint_as_float(rr[1]);}
  if(hi==0)wsf[32+r32]=l_reg;asm volatile("s_waitcnt lgkmcnt(0)":::"memory");
  float rli[16];
  #pragma unroll
  for(int r=0;r<16;++r)rli[r]=__builtin_amdgcn_rcpf(wsf[32+crow(r,hi)]);
  bf16*Ow=O+(rowbase+q0+wid*QBLK)*QP+h*D;
  { bf16*stg=(bf16*)(shm+LDS_OST)+wid*2048;
    #pragma unroll
    for(int r=0;r<16;++r){const int orow=crow(r,hi);
      #pragma unroll
      for(int d0=0;d0<2;++d0)stg[orow*64+d0*32+r32]=__float2bfloat16(o[d0][r]*rli[r]);}
    asm volatile("s_waitcnt lgkmcnt(0)":::"memory");
    #pragma unroll
    for(int i=0;i<4;++i){const int row=i*8+(lane>>3),ch=lane&7; const u32x4 v=*(const u32x4*)(stg+row*64+ch*8); ATTN_STORE16(Ow+(long)row*QP+ch*8,v);} }
  asm volatile("s_waitcnt lgkmcnt(0)\n\ts_barrier":::"memory");
  #undef DMA_K
  #undef DMA_V
  #undef START
  #undef RESC
  #undef ROT
}
constexpr int ATTN_LDS_BYTES=LDS_BYTES;
#undef SBAR
#undef WAIT_BAR
}
constexpr int NWAVES = 8;
constexpr int BATCH = 8, SEQ = 8192, DMODEL = 1024, MTOK = BATCH * SEQ;
constexpr int D_IN = 5376;
constexpr int NEXP = 32, DEXP = 512, NLIST = 64, LIST_CAP = MTOK;
constexpr float EPS = 1e-6f, HGRN_SCALE = 0.08838834764831845f;
constexpr float C2 = 0.125f * 1.4426950408889634f;

constexpr size_t MiB = 1u << 20;
constexpr size_t WS_CTL = 0, CTL_ZERO_BYTES = 262144;
constexpr size_t WS_ROPE = 1 * MiB;
constexpr size_t WS_LBV = WS_ROPE + 64 * 1024;
constexpr size_t WS_QKN = WS_LBV + 8192;
constexpr size_t WS_RSTD1 = WS_LBV + 64 * 1024;
constexpr size_t WS_RSTD2 = WS_RSTD1 + 256 * 1024;
constexpr size_t WS_WR = WS_RSTD2 + 256 * 1024;
constexpr size_t WS_TOK = WS_WR + 256 * 1024;
constexpr size_t WS_SX1 = 3 * MiB + 256 * 1024;
constexpr size_t WS_SWGU = WS_SX1 + 256 * 1024;
constexpr size_t WS_RSTD1Q = WS_SWGU + 128 * 1024;
constexpr size_t WS_SWIN = WS_RSTD1Q + 256 * 1024;
constexpr size_t WS_WIN = 4 * MiB;
constexpr size_t WS_WA = 15 * MiB, WS_WB = 16 * MiB, WS_WOUT = 17 * MiB;
constexpr size_t WS_WD = 20 * MiB;
constexpr size_t WS_Q = 244 * MiB;
constexpr size_t WS_K = 308 * MiB, WS_V = 324 * MiB;
constexpr size_t WS_X1Q = WS_Q;
constexpr size_t WS_WGUQ = 52 * MiB;
constexpr size_t WS_PMAX = 512 * 1024;
constexpr size_t WS_QEF = 340 * MiB, WS_KEF = 404 * MiB;
constexpr size_t WS_MERGED = WS_QEF, WS_HID = WS_QEF;
constexpr size_t WS_QEB = 468 * MiB, WS_KEB = 532 * MiB;
constexpr size_t WS_X1B = WS_QEB;
constexpr int Y0_PITCH = 1024 + 64;
constexpr size_t WS_Y0 = 596 * MiB;
constexpr size_t WS_VH = 596 * MiB;
constexpr size_t WS_SSQ = WS_VH;
constexpr size_t WS_AMX = WS_VH + 4 * MiB;
constexpr size_t WS_OG = 660 * MiB;
constexpr size_t WS_VEC = 724 * MiB;
constexpr size_t WS_CVEC = 740 * MiB;
constexpr size_t WS_OF = 748 * MiB, WS_OB = 812 * MiB;
constexpr size_t WS_LIST = 876 * MiB;
constexpr size_t WS_X0Q = 892 * MiB;
constexpr size_t WS_WINQ = 956 * MiB;
constexpr size_t WS_PLIST = 962 * MiB;
constexpr size_t WS_END = 990 * MiB;

constexpr int CW_TMO = 0, CW_CODE = 1;
constexpr int CW_BAR = 4096;
constexpr int CW_QHEAD = 8192;
constexpr int CW_HFLAG = 12288;
constexpr int CW_CNT = 16384;
constexpr int NPAIR = 112;
constexpr int CW_PCNT = 32768;
constexpr int CW_WINCNT = 24576;
static_assert((CW_CNT + 64 * 64) <= CW_WINCNT && CW_WINCNT + 64 <= CW_PCNT && (CW_PCNT + 16 * NPAIR) * 4 <= (int)CTL_ZERO_BYTES, "control words inside the per-call memset");

constexpr int RING_OFF = 0, RING_BYTES = 131072;
constexpr int SCAN_LDS_BYTES = 153600;
constexpr int LDSCTL_OFF = SCAN_LDS_BYTES, MISC_OFF = LDSCTL_OFF + 320;
constexpr int MOETAB_OFF = LDSCTL_OFF + 1024;
constexpr int ROPE_LDS_OFF = RING_BYTES;
constexpr int LDS_BYTES = LDSCTL_OFF + 2048;
static_assert(ROPE_LDS_OFF + 16384 + 4096 <= LDSCTL_OFF && LDS_BYTES <= 163840, "LDS map");

typedef GAS unsigned gu32;
#define RLX_AGENT __ATOMIC_RELAXED, __HIP_MEMORY_SCOPE_AGENT
#define LDS_WAIT() asm volatile("s_waitcnt lgkmcnt(0)" ::: "memory")
#define VM_WAIT() asm volatile("s_waitcnt vmcnt(0)" ::: "memory")

#define XB_TMO      128
#define XB_XCNT(j)  (256  + 64 * (j))
#define XB_XSUB(j)  (1280 + 64 * (j))
#define XB_XGEN(j)  (2304 + 64 * (j))
#define XB_TOP      3328
#define XB_TOPGEN   3392
#define XCD_BAR_WORDS 3456
#define XB_SPIN_CAP (1u << 18)

__device__ __forceinline__ unsigned xb_ld(unsigned* p)              { return __hip_atomic_load(p, __ATOMIC_RELAXED, __HIP_MEMORY_SCOPE_AGENT); }
__device__ __forceinline__ unsigned xb_add(unsigned* p, unsigned v) { return __hip_atomic_fetch_add(p, v, __ATOMIC_RELAXED, __HIP_MEMORY_SCOPE_AGENT); }
__device__ __forceinline__ unsigned xb_xcc_id() { return (unsigned)__builtin_amdgcn_s_getreg((3 << 11) | 20) & 0xFu; }
#define XB_SPIN(cond, bar) do { unsigned _sp = 0; while (cond) { __builtin_amdgcn_s_sleep(1); \
    if ((++_sp & 255u) == 0u) { if (xb_ld(&(bar)[XB_TMO])) break; if (_sp > XB_SPIN_CAP) { atomicAdd(&(bar)[XB_TMO], 1u); break; } } } } while (0)

struct XcdBarrier { unsigned* bar; unsigned x; volatile LAS unsigned* st; };

__device__ __forceinline__ XcdBarrier xcd_barrier_post(unsigned* bar, volatile LAS unsigned* st, bool leader) {
    XcdBarrier b; b.bar = bar; b.x = xb_xcc_id(); b.st = st;
    if (leader) (void)xb_add(&bar[XB_XCNT(b.x)], 1u);
    return b;
}
__device__ __forceinline__ void xcd_barrier_complete(unsigned* bar, unsigned x, unsigned& nloc, unsigned& nx) {
    const unsigned G = gridDim.x * gridDim.y * gridDim.z;
    unsigned sum, cnt, mine, sp = 0u;
    for (;;) {
        sum = 0u; cnt = 0u; mine = 0u;
#pragma unroll
        for (unsigned j = 0; j < 16; ++j) { const unsigned c = xb_ld(&bar[XB_XCNT(j)]); sum += c; cnt += (c > 0u) ? 1u : 0u; mine = (j == x) ? c : mine; }
        if (sum == G) break;
        __builtin_amdgcn_s_sleep(1);
        if ((++sp & 255u) == 0u) { if (xb_ld(&bar[XB_TMO])) break; if (sp > XB_SPIN_CAP) { atomicAdd(&bar[XB_TMO], 1u); break; } }
    }
    nloc = mine > 0u ? mine : 1u; nx = cnt > 0u ? cnt : 1u;
}
__device__ __forceinline__ void xcd_barrier(const XcdBarrier& b, bool leader) {
    asm volatile("s_waitcnt vmcnt(0)" ::: "memory");
    __syncthreads();
    if (leader) {
        unsigned* bar = b.bar;
        __builtin_amdgcn_s_waitcnt(0);
        unsigned nloc = b.st[0], nx = b.st[1];
        if (nloc == 0u) { xcd_barrier_complete(bar, b.x, nloc, nx); b.st[0] = nloc; b.st[1] = nx; }
        const unsigned old = xb_add(&bar[XB_XSUB(b.x)], 1u);
        const unsigned gen = old / nloc;
        if (old + 1u == (gen + 1u) * nloc) {
            __builtin_amdgcn_fence(__ATOMIC_RELEASE, "agent");
            asm volatile("s_waitcnt vmcnt(0)" ::: "memory");
            const unsigned og = xb_add(&bar[XB_TOP], 1u);
            const unsigned tg = og / nx;
            if (og + 1u == (tg + 1u) * nx) xb_add(&bar[XB_TOPGEN], 1u);
            else XB_SPIN(xb_ld(&bar[XB_TOPGEN]) == tg, bar);
            __builtin_amdgcn_fence(__ATOMIC_ACQUIRE, "agent");
            xb_add(&bar[XB_XGEN(b.x)], 1u);
            asm volatile("s_waitcnt vmcnt(0)" ::: "memory");
        } else {
            XB_SPIN(xb_ld(&bar[XB_XGEN(b.x)]) == gen, bar);
            __builtin_amdgcn_fence(__ATOMIC_ACQUIRE, "agent");
            asm volatile("s_waitcnt vmcnt(0)" ::: "memory");
        }
    }
    __syncthreads();
}

struct Frame {
    LAS unsigned char* lds;
    volatile LAS unsigned* MISC;
    gu32* ctl;
    int wave;
    int vcu, G;
    unsigned char* ws; float* out;
    const float* in[19];
};
__device__ __forceinline__ float wave_sum(float v) {
#pragma unroll
    for (int o = 1; o < 64; o <<= 1) v += __shfl_xor(v, o);
    return v;
}
__device__ __forceinline__ int win_colmap(int p) {
    const int pn = p >> 8, pp = p & 255;
    if (pn <= 2) return 256 * pn + 64 * ((pp >> 5) & 3) + 32 * (pp >> 7) + (pp & 31);
    if (pn <= 10) { const int T = pn - 3, bj = pp >> 7, wc = (pp >> 5) & 3, fq = (pp >> 3) & 3, n = (pp >> 2) & 1, i = pp & 3;
        const int qty = 2 * bj + n, ch = 64 * T + 16 * wc + 4 * fq + i;
        return 768 + 512 * qty + ch; }
    if (pn <= 12) return p;
    { const int T = pn - 13; return (pp < 128) ? (3328 + 128 * T + pp) : (4352 + 128 * T + (pp - 128)); }
}
template <class SrcF>
__device__ __forceinline__ void p0_item(const SrcF& src, int K, int nrows, bf16_t* WT, LAS float* scr, int item, int lane, unsigned* colmax = nullptr) {
    const int nblk = nrows / 32, kb = item / nblk, nb = item % nblk, k0 = 64 * kb, n0 = 32 * nb;
    float tv[32];
#pragma unroll
    for (int i = 0; i < 32; ++i) tv[i] = src(k0 + 2 * i + (lane >> 5), n0 + (lane & 31));
    if (colmax) { float mx = 0.f;
#pragma unroll
        for (int i = 0; i < 32; ++i) mx = fmaxf(mx, fabsf(tv[i]));
        mx = fmaxf(mx, __shfl_xor(mx, 32));
        if (lane < 32) atomicMax(colmax + n0 + lane, __float_as_uint(mx)); }
#pragma unroll
    for (int i = 0; i < 32; ++i) { const int kk = 2 * i + (lane >> 5); scr[kk * 33 + (lane & 31)] = tv[i]; }
    LDS_WAIT(); asm volatile("" ::: "memory");
    const int c = lane & 7;
#pragma unroll
    for (int j = 0; j < 4; ++j) { const int n = (lane >> 3) + 8 * j; const LAS float* s = scr + (8 * c) * 33 + n;
        u32x4 o; o.x = cvtpk(s[0 * 33], s[1 * 33]); o.y = cvtpk(s[2 * 33], s[3 * 33]); o.z = cvtpk(s[4 * 33], s[5 * 33]); o.w = cvtpk(s[6 * 33], s[7 * 33]);
        *(GAS u32x4*)(WT + (size_t)(n0 + n) * K + k0 + 8 * c) = o; }
    LDS_WAIT(); asm volatile("" ::: "memory");
}
struct SrcWin { const float* W; const float* g; __device__ __forceinline__ float operator()(int k, int p) const { return g[k] * W[(size_t)k * D_IN + win_colmap(p)]; } };
struct SrcPlain { const float* W; int N; __device__ __forceinline__ float operator()(int k, int p) const { return W[(size_t)k * N + p]; } };
struct SrcWb { const float* W; const float* g; __device__ __forceinline__ float operator()(int k, int p) const { return g[k & 127] * W[(size_t)k * 1024 + p]; } };
struct SrcGu { const float* Wg; const float* Wu; const float* g;
    __device__ __forceinline__ float operator()(int k, int p) const { const int s = (p >> 7) & 1, j = 128 * (p >> 8) + (p & 127); const float* W = (const float*)((uintptr_t)Wg + (s ? ((uintptr_t)Wu - (uintptr_t)Wg) : (uintptr_t)0)); return g[k] * W[(size_t)k * 512 + j]; } };

__device__ __forceinline__ void winq_rows(Frame& F) {
    const int gw = F.vcu * NWAVES + F.wave, NGW = F.G * NWAVES, lane = mk_lane();
    const bf16_t* Win_t = (const bf16_t*)(F.ws + WS_WIN); unsigned char* Wq = F.ws + WS_WINQ; float* sw = (float*)(F.ws + WS_SWIN);
    for (int p = gw; p < D_IN; p += NGW) {
          const u32x4 a = *(const u32x4*)(Win_t + (size_t)p * 1024 + lane * 16), b = *(const u32x4*)(Win_t + (size_t)p * 1024 + lane * 16 + 8);
          float mx = 0.f;
#pragma unroll
          for (int i = 0; i < 4; ++i) { mx = fmaxf(fmaxf(mx, fmaxf(fabsf(bf_lo(a[i])), fabsf(bf_hi(a[i])))), fmaxf(fabsf(bf_lo(b[i])), fabsf(bf_hi(b[i])))); }
#pragma unroll
          for (int o = 1; o < 64; o <<= 1) mx = fmaxf(mx, __shfl_xor(mx, o));
          const float amax = fmaxf(mx, 1e-30f), qs = 127.0f / amax;
          u32x4 q = {0u, 0u, 0u, 0u};
#pragma unroll
          for (int i = 0; i < 2; ++i) { q[i] = __builtin_amdgcn_cvt_pk_u8_f32(rintf(bf_lo(a[2 * i]) * qs) + 128.0f, 0, q[i]); q[i] = __builtin_amdgcn_cvt_pk_u8_f32(rintf(bf_hi(a[2 * i]) * qs) + 128.0f, 1, q[i]);
              q[i] = __builtin_amdgcn_cvt_pk_u8_f32(rintf(bf_lo(a[2 * i + 1]) * qs) + 128.0f, 2, q[i]); q[i] = __builtin_amdgcn_cvt_pk_u8_f32(rintf(bf_hi(a[2 * i + 1]) * qs) + 128.0f, 3, q[i]);
              q[2 + i] = __builtin_amdgcn_cvt_pk_u8_f32(rintf(bf_lo(b[2 * i]) * qs) + 128.0f, 0, q[2 + i]); q[2 + i] = __builtin_amdgcn_cvt_pk_u8_f32(rintf(bf_hi(b[2 * i]) * qs) + 128.0f, 1, q[2 + i]);
              q[2 + i] = __builtin_amdgcn_cvt_pk_u8_f32(rintf(bf_lo(b[2 * i + 1]) * qs) + 128.0f, 2, q[2 + i]); q[2 + i] = __builtin_amdgcn_cvt_pk_u8_f32(rintf(bf_hi(b[2 * i + 1]) * qs) + 128.0f, 3, q[2 + i]); }
          q = q ^ (u32x4){0x80808080u, 0x80808080u, 0x80808080u, 0x80808080u};
          *(u32x4*)(Wq + (size_t)p * 1024 + lane * 16) = q;
          if (lane == 0) sw[p] = amax * (1.0f / 127.0f); }
}
__device__ __forceinline__ void gu_absmax_task(const float* wg, const float* wu, const float* g, float* pmax, int task, int lane) {
    const int kq = task & 3, cb = (task >> 2) & 1, sgu = (task >> 3) & 1, e = task >> 4;
    const float* Wm = (const float*)((uintptr_t)wg + (sgu ? ((uintptr_t)wu - (uintptr_t)wg) : (uintptr_t)0)) + (size_t)e * 1024 * 512;
    const int j0 = 256 * cb + 4 * lane; const GAS f32x4* src = (const GAS f32x4*)(Wm + (size_t)(256 * kq) * 512 + j0);
    f32x4 m = {0.f, 0.f, 0.f, 0.f};
    for (int k = 0; k < 256; k += 16) { f32x4 w[16];
#pragma unroll
        for (int i = 0; i < 16; ++i) w[i] = src[(size_t)(k + i) * 128];
#pragma unroll
        for (int i = 0; i < 16; ++i) { const float ga = fabsf(g[256 * kq + k + i]);
            m[0] = fmaxf(m[0], fabsf(w[i][0]) * ga); m[1] = fmaxf(m[1], fabsf(w[i][1]) * ga); m[2] = fmaxf(m[2], fabsf(w[i][2]) * ga); m[3] = fmaxf(m[3], fabsf(w[i][3]) * ga); } }
    const int p = 256 * (j0 >> 7) + 128 * sgu + (j0 & 127);
    *(GAS f32x4*)(pmax + ((size_t)(kq * 32 + e) * 1024 + p)) = m;
}
template <class SrcF>
__device__ __forceinline__ void p0_item_q8(const SrcF& src, unsigned char* WQ, float* sw, const float* pmax_e, LAS float* scr, int item, int lane) {
    const int kb = item / 32, nb = item % 32, k0 = 64 * kb, n0 = 32 * nb;
    float tv[32];
#pragma unroll
    for (int i = 0; i < 32; ++i) tv[i] = src(k0 + 2 * i + (lane >> 5), n0 + (lane & 31));
#pragma unroll
    for (int i = 0; i < 32; ++i) { const int kk = 2 * i + (lane >> 5); scr[kk * 33 + (lane & 31)] = tv[i]; }
    LDS_WAIT(); asm volatile("" ::: "memory");
    const int c = lane & 7;
#pragma unroll
    for (int j = 0; j < 4; ++j) { const int n = (lane >> 3) + 8 * j, row = n0 + n; const LAS float* s = scr + (8 * c) * 33 + n;
        const float amax = fmaxf(fmaxf(fmaxf(pmax_e[row], pmax_e[32 * 1024 + row]), fmaxf(pmax_e[2 * 32 * 1024 + row], pmax_e[3 * 32 * 1024 + row])), 1e-30f), qs = 127.0f / amax;
        unsigned q0 = 0u, q1 = 0u;
        q0 = __builtin_amdgcn_cvt_pk_u8_f32(rintf(s[0 * 33] * qs) + 128.0f, 0, q0); q0 = __builtin_amdgcn_cvt_pk_u8_f32(rintf(s[1 * 33] * qs) + 128.0f, 1, q0);
        q0 = __builtin_amdgcn_cvt_pk_u8_f32(rintf(s[2 * 33] * qs) + 128.0f, 2, q0); q0 = __builtin_amdgcn_cvt_pk_u8_f32(rintf(s[3 * 33] * qs) + 128.0f, 3, q0);
        q1 = __builtin_amdgcn_cvt_pk_u8_f32(rintf(s[4 * 33] * qs) + 128.0f, 0, q1); q1 = __builtin_amdgcn_cvt_pk_u8_f32(rintf(s[5 * 33] * qs) + 128.0f, 1, q1);
        q1 = __builtin_amdgcn_cvt_pk_u8_f32(rintf(s[6 * 33] * qs) + 128.0f, 2, q1); q1 = __builtin_amdgcn_cvt_pk_u8_f32(rintf(s[7 * 33] * qs) + 128.0f, 3, q1);
        *(GAS u32x2*)(WQ + (size_t)row * 1024 + k0 + 8 * c) = (u32x2){q0 ^ 0x80808080u, q1 ^ 0x80808080u};
        if (kb == 0 && c == 0) sw[row] = amax * (1.0f / 127.0f); }
    LDS_WAIT(); asm volatile("" ::: "memory");
}
__device__ __forceinline__ void p0_prologue(Frame& F) {
    LAS float* scr = (LAS float*)(F.lds + RING_OFF + F.wave * 16384);
    const int gw = F.vcu * NWAVES + F.wave, NGW = F.G * NWAVES;
    const float* g_mix = F.in[1]; const float* w_in = F.in[2]; const float* hgrn_norm = F.in[5];
    const float* w_attn = F.in[8]; const float* w_hgrn = F.in[9]; const float* w_out = F.in[10]; const float* g_ffn = F.in[11];
    const float* w_gate = F.in[16]; const float* w_up = F.in[17]; const float* w_down = F.in[18];
    bf16_t* Win_t = (bf16_t*)(F.ws + WS_WIN); bf16_t* Wa_t = (bf16_t*)(F.ws + WS_WA); bf16_t* Wb_t = (bf16_t*)(F.ws + WS_WB); bf16_t* Wout_t = (bf16_t*)(F.ws + WS_WOUT);
    bf16_t* Wd_t = (bf16_t*)(F.ws + WS_WD); float* pmax = (float*)(F.ws + WS_PMAX);
    constexpr int I_IN = (1024 / 64) * (D_IN / 32), I_A = (512 / 64) * (1024 / 32), I_OUT = (1024 / 64) * (1024 / 32);
    constexpr int I_GU1 = (1024 / 64) * (1024 / 32), I_D1 = (512 / 64) * (1024 / 32);
    constexpr int NITEMS = 2 * I_A + I_OUT + NEXP * I_D1, NGUT = NEXP * 16;
    for (int it = gw; it < I_IN + NGUT; it += NGW) {
        if (it < I_IN) p0_item(SrcWin{w_in, g_mix}, 1024, D_IN, Win_t, scr, it, mk_lane());
        else gu_absmax_task(w_gate, w_up, g_ffn, pmax, it - I_IN, mk_lane()); }
    __syncthreads();
    if (F.wave == 0 && mk_lane() == 0) { __builtin_amdgcn_fence(__ATOMIC_RELEASE, "agent"); asm volatile("s_waitcnt vmcnt(0)" ::: "memory"); __hip_atomic_fetch_add((unsigned*)(F.ctl + CW_WINCNT), 1u, RLX_AGENT); }
    for (int it = (gw + NGW / 2) % NGW; it < NITEMS; it += NGW) {
        int r = it;
        if (r < I_A) { p0_item(SrcPlain{w_attn, 1024}, 512, 1024, Wa_t, scr, r, mk_lane()); continue; } r -= I_A;
        if (r < I_A) { p0_item(SrcWb{w_hgrn, hgrn_norm}, 512, 1024, Wb_t, scr, r, mk_lane()); continue; } r -= I_A;
        if (r < I_OUT) { p0_item(SrcPlain{w_out, 1024}, 1024, 1024, Wout_t, scr, r, mk_lane()); continue; } r -= I_OUT;
        { const int e = r / I_D1, q = r % I_D1; p0_item(SrcPlain{w_down + (size_t)e * 512 * 1024, 1024}, 512, 1024, Wd_t + (size_t)e * 1024 * 512, scr, q, mk_lane()); }
    }
    { const float* x = F.in[0]; float* rstd1 = (float*)(F.ws + WS_RSTD1); float* rstd1q = (float*)(F.ws + WS_RSTD1Q); unsigned char* X0Q = F.ws + WS_X0Q;
      for (int m0 = gw * 4; m0 < MTOK; m0 += NGW * 4) {
          f32x4 v[4][4]; float s[4], a[4];
#pragma unroll
          for (int r = 0; r < 4; ++r) { const GAS f32x4* xr = (const GAS f32x4*)(x + (size_t)(m0 + r) * DMODEL) + mk_lane();
#pragma unroll
              for (int j = 0; j < 4; ++j) v[r][j] = xr[64 * j]; }
#pragma unroll
          for (int r = 0; r < 4; ++r) { float t = 0.f;
#pragma unroll
              for (int j = 0; j < 4; ++j) t += (v[r][j].x * v[r][j].x + v[r][j].y * v[r][j].y) + (v[r][j].z * v[r][j].z + v[r][j].w * v[r][j].w);
              s[r] = t; float mx = 0.f;
#pragma unroll
              for (int j = 0; j < 4; ++j) mx = fmaxf(fmaxf(mx, fmaxf(fabsf(v[r][j].x), fabsf(v[r][j].y))), fmaxf(fabsf(v[r][j].z), fabsf(v[r][j].w)));
              a[r] = mx; }
#pragma unroll
          for (int o = 1; o < 64; o <<= 1) {
#pragma unroll
              for (int r = 0; r < 4; ++r) { s[r] += __shfl_xor(s[r], o); a[r] = fmaxf(a[r], __shfl_xor(a[r], o)); } }
          const int ln = mk_lane();
          if (ln < 4) { const float sv = ln == 0 ? s[0] : ln == 1 ? s[1] : ln == 2 ? s[2] : s[3]; const float av = fmaxf(ln == 0 ? a[0] : ln == 1 ? a[1] : ln == 2 ? a[2] : a[3], 1e-30f);
              const float rs = 1.0f / sqrtf(sv * (1.0f / DMODEL) + EPS); rstd1[m0 + ln] = rs; rstd1q[m0 + ln] = rs * av * (1.0f / 127.0f); }
#pragma unroll
          for (int r = 0; r < 4; ++r) { const float qs = 127.0f / fmaxf(a[r], 1e-30f); GAS unsigned* o4 = (GAS unsigned*)(X0Q + (size_t)(m0 + r) * DMODEL) + ln;
#pragma unroll
              for (int j = 0; j < 4; ++j) { unsigned q = 0u; q = __builtin_amdgcn_cvt_pk_u8_f32(rintf(v[r][j].x * qs) + 128.0f, 0, q); q = __builtin_amdgcn_cvt_pk_u8_f32(rintf(v[r][j].y * qs) + 128.0f, 1, q);
                  q = __builtin_amdgcn_cvt_pk_u8_f32(rintf(v[r][j].z * qs) + 128.0f, 2, q); q = __builtin_amdgcn_cvt_pk_u8_f32(rintf(v[r][j].w * qs) + 128.0f, 3, q); o4[64 * j] = q ^ 0x80808080u; } }
      } }
    const int gt = F.vcu * (NWAVES * 64) + (F.wave * 64 + mk_lane()), NGT = F.G * NWAVES * 64;
    { f32x2* rope = (f32x2*)(F.ws + WS_ROPE);
      for (int i = gt; i < 128 * 16; i += NGT) { const int pos = i >> 4, j = i & 15; const float inv = powf(10000.0f, -(float)(2 * j) / 32.0f); const float ang = (float)pos * inv;
          rope[i] = (f32x2){cosf(ang), sinf(ang)}; } }
    { float* lbv = (float*)(F.ws + WS_LBV); const float* lbf = F.in[6]; const float* lbb = F.in[7];
      for (int i = gt; i < 512; i += NGT) { const float a0 = lbf[i], a1 = lbf[512 + i]; const float mx = fmaxf(a0, a1), e0 = expf(a0 - mx), e1 = expf(a1 - mx); lbv[i] = e0 / (e0 + e1); }
      for (int i = gt; i < 512; i += NGT) { const float a0 = lbb[i], a1 = lbb[512 + i]; const float mx = fmaxf(a0, a1), e0 = expf(a0 - mx), e1 = expf(a1 - mx); lbv[512 + i] = e0 / (e0 + e1); }
      float* qkn = (float*)(F.ws + WS_QKN); const float* qn = F.in[3]; const float* kn = F.in[4];
      for (int i = gt; i < 64; i += NGT) { qkn[i] = qn[i]; qkn[64 + i] = kn[i]; }
      if (gt == 0) { float gq = 0.f, gk = 0.f; for (int i = 0; i < 64; ++i) { gq = fmaxf(gq, fabsf(qn[i])); gk = fmaxf(gk, fabsf(kn[i])); }
          qkn[128] = 8.0f * 1.4426950408889634f * gq * gk * 1.01f + 0.125f; } }
    { bf16_t* Wr = (bf16_t*)(F.ws + WS_WR); const float* wrg = F.in[12]; const float* wre = F.in[14];
      for (int i = gt; i < 48 * 1024; i += NGT) { const int j = i >> 10, k = i & 1023;
          float v = 0.f; if (j < 4) v = g_ffn[k] * wrg[k * 4 + j]; else if (j < 36) v = g_ffn[k] * wre[k * 32 + (j - 4)];
          const unsigned hb = cvtpk(v, 0.f) & 0xffffu; const float hf = __uint_as_float(hb << 16); const unsigned lb = cvtpk(v - hf, 0.f) & 0xffffu;
          Wr[i] = (bf16_t)hb; Wr[48 * 1024 + i] = (bf16_t)lb; } }
    if (F.wave == 0) { unsigned sp = 0; while (__builtin_amdgcn_readfirstlane((int)__hip_atomic_load((unsigned*)(F.ctl + CW_WINCNT), RLX_AGENT)) < F.G) { __builtin_amdgcn_s_sleep(8); if (++sp > (1u << 22)) break; }
      __builtin_amdgcn_fence(__ATOMIC_ACQUIRE, "agent"); asm volatile("s_waitcnt vmcnt(0)" ::: "memory"); }
    __syncthreads();
    winq_rows(F);
    for (int it = gw; it < NEXP * I_GU1; it += NGW) { const int e = it / I_GU1, q = it % I_GU1;
        p0_item_q8(SrcGu{w_gate + (size_t)e * 1024 * 512, w_up + (size_t)e * 1024 * 512, g_ffn}, F.ws + WS_WGUQ + (size_t)e * 1024 * 1024, (float*)(F.ws + WS_SWGU) + e * 1024, pmax + (size_t)e * 1024, scr, q, mk_lane()); }
}
using pg8::GUnit;
struct DenseOrder {
    pg8::TileOrder T; const char* A; const char* Bt; int K; int pn_split = 1 << 20, pn_skip = 0, pn_off = 0;
    __device__ __forceinline__ bool next(int i, GUnit& u) const { int pm, pn; if (!T.tile(i, pm, pn)) return false; pn = (pn < pn_split ? pn : pn + pn_skip) + pn_off; u.pm = pm; u.pn = pn; u.seg = 1; u.aux = 0;
        u.Ab = A + (size_t)pm * 256 * K * 2; u.Bb = Bt + (size_t)pn * 256 * K * 2; return true; }
    __device__ __forceinline__ void aoff(const GUnit&, const int (&R)[2], const int (&C)[2], unsigned (&o)[2][2]) const {
#pragma unroll
        for (int h = 0; h < 2; ++h)
#pragma unroll
            for (int i = 0; i < 2; ++i) o[h][i] = (unsigned)(((h * 128 + R[i]) * K + C[i]) * 2); }
    __device__ __forceinline__ void aoff_raw(const GUnit& u, const int (&R)[2], const int (&C)[2], unsigned (&o)[2][2]) const { aoff(u, R, C, o); }
    __device__ __forceinline__ void aoff_fin(const GUnit&, unsigned (&)[2][2], const int (&)[2]) const {}
};
struct Seg2Order {
    pg8::TileOrder T; const char* ws; int K;
    __device__ __forceinline__ bool next(int i, GUnit& u) const { int pm, pn; if (!T.tile(i >> 1, pm, pn)) return false; const int s = i & 1; u.pm = pm; u.pn = pn; u.seg = s; u.aux = 0;
        u.Ab = ws + (s ? WS_OG : WS_Q) + (size_t)pm * 256 * K * 2; u.Bb = ws + (s ? WS_WB : WS_WA) + (size_t)pn * 256 * K * 2; return true; }
    __device__ __forceinline__ void aoff(const GUnit&, const int (&R)[2], const int (&C)[2], unsigned (&o)[2][2]) const {
#pragma unroll
        for (int h = 0; h < 2; ++h)
#pragma unroll
            for (int i = 0; i < 2; ++i) o[h][i] = (unsigned)(((h * 128 + R[i]) * K + C[i]) * 2); }
    __device__ __forceinline__ void aoff_raw(const GUnit& u, const int (&R)[2], const int (&C)[2], unsigned (&o)[2][2]) const { aoff(u, R, C, o); }
    __device__ __forceinline__ void aoff_fin(const GUnit&, unsigned (&)[2][2], const int (&)[2]) const {}
};
struct MoeOrder {
    const LAS int* tab; int nl, lst0, lstep; const int* lists; const char* A; const char* W; size_t wstride; int K; int G, c;
    __device__ __forceinline__ bool next(int i, GUnit& u) const {
        const int total = tab[nl] * 4; const long L = (long)i * G + c; if (L >= total) return false;
        const int u4 = (int)L >> 2; int j = 0;
        for (int st = 32; st > 0; st >>= 1) { const int t = j + st; if (t < nl && tab[t] <= u4) j = t; }
        const int li = lst0 + lstep * j;
        u.pm = u4 - tab[j]; u.pn = (int)L & 3; u.seg = 1; u.aux = li;
        u.Ab = A; u.Bb = W + (size_t)(li >> 1) * wstride + (size_t)u.pn * 256 * K * 2; return true; }
    __device__ __forceinline__ void aoff(const GUnit& u, const int (&R)[2], const int (&C)[2], unsigned (&o)[2][2]) const {
        const int n = tab[80 + u.aux]; const GAS int* lp = (const GAS int*)lists + (size_t)u.aux * LIST_CAP;
#pragma unroll
        for (int h = 0; h < 2; ++h)
#pragma unroll
            for (int i = 0; i < 2; ++i) { int ridx = u.pm * 256 + h * 128 + R[i]; ridx = ridx < n ? ridx : n - 1; const int tok = lp[ridx]; o[h][i] = (unsigned)((tok * K + C[i]) * 2); } }
    __device__ __forceinline__ void aoff_raw(const GUnit& u, const int (&R)[2], const int (&)[2], unsigned (&o)[2][2]) const {
        const int n = tab[80 + u.aux]; const GAS int* lp = (const GAS int*)lists + (size_t)u.aux * LIST_CAP;
#pragma unroll
        for (int h = 0; h < 2; ++h)
#pragma unroll
            for (int i = 0; i < 2; ++i) { int ridx = u.pm * 256 + h * 128 + R[i]; ridx = ridx < n ? ridx : n - 1; o[h][i] = (unsigned)lp[ridx]; } }
    __device__ __forceinline__ void aoff_fin(const GUnit&, unsigned (&o)[2][2], const int (&C)[2]) const {
#pragma unroll
        for (int h = 0; h < 2; ++h)
#pragma unroll
            for (int i = 0; i < 2; ++i) o[h][i] = (o[h][i] * (unsigned)K + (unsigned)C[i]) * 2u; }
};

struct PairOrder {
    static constexpr int CNT0 = 116;
    const LAS int* tab; const unsigned* plist; const char* HID; const char* W; size_t wstride; int K; int G, c;
    __device__ __forceinline__ bool next(int i, GUnit& u) const {
        const int total = tab[NPAIR] * 4; const long L = (long)(i >> 1) * G + c; if (L >= total) return false;
        const int u4 = (int)L >> 2; int l = 0;
        for (int st = 64; st > 0; st >>= 1) { const int t = l + st; if (t < NPAIR && tab[t] <= u4) l = t; }
        const int g = l / 28; int p = l - 28 * g, a = 0;
        while (p >= 7 - a) { p -= 7 - a; ++a; }
        const int b = a + 1 + p, s = i & 1;
        u.pm = u4 - tab[l]; u.pn = (int)L & 3; u.seg = s; u.aux = l;
        u.Ab = HID; u.Bb = W + (size_t)(8 * g + (s ? b : a)) * wstride + (size_t)u.pn * 256 * K * 2; return true; }
    __device__ __forceinline__ void aoff_raw(const GUnit& u, const int (&R)[2], const int (&)[2], unsigned (&o)[2][2]) const {
        const int n = tab[CNT0 + u.aux]; const GAS unsigned* lp = (const GAS unsigned*)plist + (size_t)u.aux * LIST_CAP;
#pragma unroll
        for (int h = 0; h < 2; ++h)
#pragma unroll
            for (int i = 0; i < 2; ++i) { int ridx = u.pm * 256 + h * 128 + R[i]; ridx = ridx < n ? ridx : n - 1; o[h][i] = lp[ridx]; } }
    __device__ __forceinline__ void aoff_fin(const GUnit& u, unsigned (&o)[2][2], const int (&C)[2]) const {
#pragma unroll
        for (int h = 0; h < 2; ++h)
#pragma unroll
            for (int i = 0; i < 2; ++i) { const unsigned e = o[h][i], slot = (e >> 31) ^ (unsigned)u.seg, tk = e & 0x7fffffffu; o[h][i] = ((slot * (unsigned)MTOK + tk) * (unsigned)K + (unsigned)C[i]) * 2u; } }
    __device__ __forceinline__ void aoff(const GUnit& u, const int (&R)[2], const int (&C)[2], unsigned (&o)[2][2]) const { aoff_raw(u, R, C, o); aoff_fin(u, o, C); }
};

template <bool I8, bool QUAD> struct EpiInProj {
    static constexpr bool SEG2 = false;
    const LAS f32x4* ropeL;
    unsigned char* ws; unsigned char* outb;
    __device__ __forceinline__ void operator()(f32x4 (&acc)[2][2][4][2], const GUnit& u, int wr, int wc, int fr, int fq) const {
        { const int l_ = mk_lane(); fr = l_ & 15; fq = l_ >> 4; }
        const int pn = u.pn, row0 = u.pm * 256 + wr * 64 + fr;
        unsigned char* ws = this->ws; unsigned char* outb = this->outb; asm volatile("" : "+s"(ws), "+s"(outb));
        const GAS float* rstd1 = (const GAS float*)(ws + (I8 ? WS_RSTD1Q : WS_RSTD1)); const GAS f32x2* rope = (const GAS f32x2*)(ws + WS_ROPE); const GAS float* lbv = (const GAS float*)(ws + WS_LBV);
        GAS bf16_t* Q = (GAS bf16_t*)(ws + WS_Q); GAS bf16_t* Kb = (GAS bf16_t*)(ws + WS_K); GAS bf16_t* Vb = (GAS bf16_t*)(ws + WS_V);
        GAS bf16_t* QEF = (GAS bf16_t*)(ws + WS_QEF); GAS bf16_t* KEF = (GAS bf16_t*)(ws + WS_KEF); GAS bf16_t* QEB = (GAS bf16_t*)(ws + WS_QEB); GAS bf16_t* KEB = (GAS bf16_t*)(ws + WS_KEB); GAS bf16_t* VH = (GAS bf16_t*)(ws + WS_VH);
        GAS float* VEC = (GAS float*)(ws + WS_VEC);
        if (I8) { f32x4 sw[2][2]; const GAS float* swp = (const GAS float*)(ws + WS_SWIN) + 256 * pn + 32 * wc + 8 * fq;
#pragma unroll
            for (int bj = 0; bj < 2; ++bj)
#pragma unroll
                for (int n = 0; n < 2; ++n) sw[bj][n] = *(const GAS f32x4*)(swp + 128 * bj + 4 * n);
            asm volatile("" : "+v"(sw[0][0]), "+v"(sw[0][1]), "+v"(sw[1][0]), "+v"(sw[1][1]));
#pragma unroll
            for (int ai = 0; ai < 2; ++ai)
#pragma unroll
                for (int bj = 0; bj < 2; ++bj)
#pragma unroll
                    for (int m = 0; m < 4; ++m)
#pragma unroll
                        for (int n = 0; n < 2; ++n)
#pragma unroll
                            for (int i = 0; i < 4; ++i) acc[ai][bj][m][n][i] = (float)__float_as_int(acc[ai][bj][m][n][i]) * sw[bj][n][i]; __builtin_amdgcn_sched_barrier(0); }
        float rsv[2][4];
#pragma unroll
        for (int ai = 0; ai < 2; ++ai)
#pragma unroll
            for (int m = 0; m < 4; ++m) rsv[ai][m] = rstd1[row0 + ai * 128 + m * 16];
        asm volatile("" : "+v"(rsv[0][0]), "+v"(rsv[0][1]), "+v"(rsv[0][2]), "+v"(rsv[0][3]), "+v"(rsv[1][0]), "+v"(rsv[1][1]), "+v"(rsv[1][2]), "+v"(rsv[1][3]));
        if (!QUAD && pn <= 2) {
            const bool isq = pn < 2, isk = (pn == 2) && (wc < 2);
            if (isq || isk) {
                const GAS float* gn = (const GAS float*)(ws + WS_QKN) + (isq ? 0 : 64); float g[2][2][4];
#pragma unroll
                for (int bj = 0; bj < 2; ++bj)
#pragma unroll
                    for (int n = 0; n < 2; ++n) { const f32x4 t = *(const GAS f32x4*)(gn + 32 * bj + 8 * fq + 4 * n); g[bj][n][0] = t[0]; g[bj][n][1] = t[1]; g[bj][n][2] = t[2]; g[bj][n][3] = t[3]; }
                const float osc = isq ? C2 : 1.0f;
#pragma unroll
                for (int ai = 0; ai < 2; ++ai) {
#pragma unroll
                    for (int m = 0; m < 4; ++m) {
                        const int row = row0 + ai * 128 + m * 16; const float rs = rsv[ai][m];
                        f32x4 v[2][2]; float ss = 0.f;
#pragma unroll
                        for (int bj = 0; bj < 2; ++bj)
#pragma unroll
                            for (int n = 0; n < 2; ++n) { v[bj][n] = acc[ai][bj][m][n] * rs; const f32x4 t = v[bj][n]; ss += (t[0] * t[0] + t[1] * t[1]) + (t[2] * t[2] + t[3] * t[3]); }
                        ss += __shfl_xor(ss, 16); ss += __shfl_xor(ss, 32);
                        const float rn = 1.0f / sqrtf(ss * (1.0f / 64.0f) + EPS) ;
                        const int t_ = row & (SEQ - 1);
#pragma unroll
                        for (int bj = 0; bj < 2; ++bj) {
                            const int pos = bj ? (t_ & 63) : (t_ >> 6); unsigned w[4];
#pragma unroll
                            for (int n = 0; n < 2; ++n) {
                                const f32x4 cs = ropeL[pos * 8 + 2 * fq + n];
                                const float a0 = v[bj][n][0] * rn * g[bj][n][0], b0 = v[bj][n][1] * rn * g[bj][n][1];
                                const float a1 = v[bj][n][2] * rn * g[bj][n][2], b1 = v[bj][n][3] * rn * g[bj][n][3];
                                const float o0 = (a0 * cs[0] - b0 * cs[1]) * osc, o1 = (a0 * cs[1] + b0 * cs[0]) * osc;
                                const float o2 = (a1 * cs[2] - b1 * cs[3]) * osc, o3 = (a1 * cs[3] + b1 * cs[2]) * osc;
                                w[2 * n] = cvtpk(o0, o1); w[2 * n + 1] = cvtpk(o2, o3);
                            }
                            const u32x4 ww = {w[0], w[1], w[2], w[3]};
                            if (isq) *(GAS u32x4*)(Q + (size_t)row * 512 + 256 * pn + 64 * wc + 32 * bj + 8 * fq) = ww;
                            else     *(GAS u32x4*)(Kb + (size_t)row * 128 + 64 * wc + 32 * bj + 8 * fq) = ww;
                        }
                    }
                }
            } else {
#pragma unroll
                for (int ai = 0; ai < 2; ++ai)
#pragma unroll
                    for (int m = 0; m < 4; ++m) { const int row = row0 + ai * 128 + m * 16; const float rs = rsv[ai][m];
#pragma unroll
                        for (int bj = 0; bj < 2; ++bj) { const f32x4 x0 = acc[ai][bj][m][0] * rs, x1 = acc[ai][bj][m][1] * rs;
                            const u32x4 ww = {cvtpk(x0[0], x0[1]), cvtpk(x0[2], x0[3]), cvtpk(x1[0], x1[1]), cvtpk(x1[2], x1[3])};
                            *(GAS u32x4*)(Vb + (size_t)row * 128 + 64 * (wc - 2) + 32 * bj + 8 * fq) = ww; } }
            }
        } else if (QUAD) {
            const int ch0 = 64 * (pn - 3) + 16 * wc + 4 * fq;
            const int l0 = fq << 4, l15 = l0 | 15;
#pragma unroll
            for (int ai = 0; ai < 2; ++ai)
#pragma unroll
                for (int cp = 0; cp < 2; ++cp) {
                    const int rlo = row0 + ai * 128 + (2 * cp) * 16, rhi = rlo + 16;
                    const float rs_lo = rsv[ai][2 * cp], rs_hi = rsv[ai][2 * cp + 1];
                    const LAS float* lbL = (const LAS float*)(ropeL + 1024); const f32x4 lbf4 = *(const LAS f32x4*)(lbL + ch0), lbb4 = *(const LAS f32x4*)(lbL + 512 + ch0);
                    unsigned wqf[2][2], wkf[2][2], wqb[2][2], wkb[2][2], wv[2][2];
                    f32x4 eref_f4, g_f4, eref_b4, g_b4;
#pragma unroll
                    for (int ip = 0; ip < 2; ++ip) {
                        float oqf[2][2], okf[2][2], oqb[2][2], okb[2][2], ov[2][2];
#pragma unroll
                        for (int ii = 0; ii < 2; ++ii) {
                            const int i = 2 * ip + ii;
                            const float omf = 1.0f - lbf4[i], omb = 1.0f - lbb4[i];
                            const float hq_lo = acc[ai][0][2 * cp][0][i] * rs_lo, hq_hi = acc[ai][0][2 * cp + 1][0][i] * rs_hi;
                            const float zf_lo = acc[ai][0][2 * cp][1][i] * rs_lo, zf_hi = acc[ai][0][2 * cp + 1][1][i] * rs_hi;
                            const float zb_lo = acc[ai][1][2 * cp][0][i] * rs_lo, zb_hi = acc[ai][1][2 * cp + 1][0][i] * rs_hi;
                            ov[0][ii] = acc[ai][1][2 * cp][1][i] * rs_lo; ov[1][ii] = acc[ai][1][2 * cp + 1][1][i] * rs_hi;
                            const float q_lo = siluf_(hq_lo) * HGRN_SCALE, q_hi = siluf_(hq_hi) * HGRN_SCALE;
                            const float kf_lo = omf * fast_rcp(1.0f + fast_exp(zf_lo)), kf_hi = omf * fast_rcp(1.0f + fast_exp(zf_hi));
                            const float kb_lo = omb * fast_rcp(1.0f + fast_exp(zb_lo)), kb_hi = omb * fast_rcp(1.0f + fast_exp(zb_hi));
                            const float ff_lo = 1.0f - kf_lo, ff_hi = 1.0f - kf_hi, fb_lo = 1.0f - kb_lo, fb_hi = 1.0f - kb_hi;
                            float IP = (fr == 0) ? 1.0f : ff_hi;
                            float IS = ff_lo;
                            float PB = (fr == 15) ? 1.0f : fb_lo;
                            float IH = fb_hi;
                            float ES = 1.0f, EH = 1.0f;
                            asm volatile("s_nop 1\n\t"
                                "v_mul_f32_dpp %0, %0, %0 row_shr:1 row_mask:0xf bank_mask:0xf\n\tv_mul_f32_dpp %1, %1, %1 row_shl:1 row_mask:0xf bank_mask:0xf\n\tv_mul_f32_dpp %2, %2, %2 row_shl:1 row_mask:0xf bank_mask:0xf\n\tv_mul_f32_dpp %3, %3, %3 row_shr:1 row_mask:0xf bank_mask:0xf\n\t"
                                "v_mul_f32_dpp %0, %0, %0 row_shr:2 row_mask:0xf bank_mask:0xf\n\tv_mul_f32_dpp %1, %1, %1 row_shl:2 row_mask:0xf bank_mask:0xf\n\tv_mul_f32_dpp %2, %2, %2 row_shl:2 row_mask:0xf bank_mask:0xf\n\tv_mul_f32_dpp %3, %3, %3 row_shr:2 row_mask:0xf bank_mask:0xf\n\t"
                                "v_mul_f32_dpp %0, %0, %0 row_shr:4 row_mask:0xf bank_mask:0xf\n\tv_mul_f32_dpp %1, %1, %1 row_shl:4 row_mask:0xf bank_mask:0xf\n\tv_mul_f32_dpp %2, %2, %2 row_shl:4 row_mask:0xf bank_mask:0xf\n\tv_mul_f32_dpp %3, %3, %3 row_shr:4 row_mask:0xf bank_mask:0xf\n\t"
                                "v_mul_f32_dpp %0, %0, %0 row_shr:8 row_mask:0xf bank_mask:0xf\n\tv_mul_f32_dpp %1, %1, %1 row_shl:8 row_mask:0xf bank_mask:0xf\n\tv_mul_f32_dpp %2, %2, %2 row_shl:8 row_mask:0xf bank_mask:0xf\n\tv_mul_f32_dpp %3, %3, %3 row_shr:8 row_mask:0xf bank_mask:0xf\n\t"
                                "s_nop 0\n\tv_mov_b32_dpp %4, %1 row_shl:1 row_mask:0xf bank_mask:0xf\n\tv_mov_b32_dpp %5, %3 row_shr:1 row_mask:0xf bank_mask:0xf\n\ts_nop 0"
                                : "+v"(IP), "+v"(IS), "+v"(PB), "+v"(IH), "+v"(ES), "+v"(EH));
                            const float hi0 = __shfl(ff_hi, l0);
                            const float Qf = ES * hi0;
                            oqf[0][ii] = q_lo * fast_rcp(Qf); okf[0][ii] = kf_lo * Qf;
                            oqf[1][ii] = q_hi * IP;           okf[1][ii] = kf_hi * fast_rcp(IP);
                            eref_f4[i] = IS * hi0;
                            g_f4[i] = IP;
                            const float lo15 = __shfl(fb_lo, l15);
                            const float Qb = EH * lo15;
                            oqb[0][ii] = q_lo * PB;           okb[0][ii] = kb_lo * fast_rcp(PB);
                            oqb[1][ii] = q_hi * fast_rcp(Qb); okb[1][ii] = kb_hi * Qb;
                            g_b4[i] = PB;
                            eref_b4[i] = IH * lo15;
                        }
#pragma unroll
                        for (int hl = 0; hl < 2; ++hl) { wqf[hl][ip] = cvtpk(oqf[hl][0], oqf[hl][1]); wkf[hl][ip] = cvtpk(okf[hl][0], okf[hl][1]);
                            wqb[hl][ip] = cvtpk(oqb[hl][0], oqb[hl][1]); wkb[hl][ip] = cvtpk(okb[hl][0], okb[hl][1]); wv[hl][ip] = cvtpk(ov[hl][0], ov[hl][1]); }
                    }
#pragma unroll
                    for (int hl = 0; hl < 2; ++hl) { const size_t o = (size_t)(hl ? rhi : rlo) * 512 + ch0;
                        *(GAS u32x2*)(QEF + o) = (u32x2){wqf[hl][0], wqf[hl][1]}; *(GAS u32x2*)(KEF + o) = (u32x2){wkf[hl][0], wkf[hl][1]};
                        *(GAS u32x2*)(QEB + o) = (u32x2){wqb[hl][0], wqb[hl][1]}; *(GAS u32x2*)(KEB + o) = (u32x2){wkb[hl][0], wkb[hl][1]};
                        *(GAS u32x2*)(VH + o) = (u32x2){wv[hl][0], wv[hl][1]}; }
                    const size_t vo = (size_t)(rlo >> 5) * 512 + ch0;
                    if (fr == 0)  { *(GAS f32x4*)(VEC + 0 * (size_t)2048 * 512 + vo) = eref_f4; *(GAS f32x4*)(VEC + 3 * (size_t)2048 * 512 + vo) = g_b4; }
                    if (fr == 15) { *(GAS f32x4*)(VEC + 1 * (size_t)2048 * 512 + vo) = g_f4;    *(GAS f32x4*)(VEC + 2 * (size_t)2048 * 512 + vo) = eref_b4; }
                    __builtin_amdgcn_sched_barrier(0);
                }
        } else {
            if (pn <= 12) {
                GAS bf16_t* dst = (GAS bf16_t*)(ws + WS_OG); const int cb = 256 * (pn - 11);
#pragma unroll
                for (int ai = 0; ai < 2; ++ai)
#pragma unroll
                    for (int m = 0; m < 4; ++m) { const int row = row0 + ai * 128 + m * 16; const float rs = rsv[ai][m];
#pragma unroll
                        for (int bj = 0; bj < 2; ++bj) { const f32x4 x0 = acc[ai][bj][m][0] * rs, x1 = acc[ai][bj][m][1] * rs;
                            const u32x4 ww = {cvtpk(x0[0], x0[1]), cvtpk(x0[2], x0[3]), cvtpk(x1[0], x1[1]), cvtpk(x1[2], x1[3])};
                            *(GAS u32x4*)(dst + (size_t)row * 512 + cb + 128 * bj + 32 * wc + 8 * fq) = ww; } }
            } else {
                GAS unsigned char* GAB = (GAS unsigned char*)outb; const int cb = 128 * (pn - 13) + 32 * wc + 8 * fq;
#pragma unroll
                for (int ai = 0; ai < 2; ++ai)
#pragma unroll
                    for (int m = 0; m < 4; ++m) { const int row = row0 + ai * 128 + m * 16; const float rs = rsv[ai][m] * -1.4426950408889634f;
                        u32x4 w = {0u, 0u, 0u, 0u};
#pragma unroll
                        for (int n = 0; n < 2; ++n)
#pragma unroll
                            for (int i = 0; i < 4; ++i) { const float ea = 1.0f + __builtin_amdgcn_exp2f(acc[ai][0][m][n][i] * rs), eb = 1.0f + __builtin_amdgcn_exp2f(acc[ai][1][m][n][i] * rs);
                                const float qa = rintf(255.0f * fast_rcp(ea)), qb = fmaxf(rintf(255.0f * fast_rcp(eb)), 1.0f); const int c = 4 * n + i;
                                w[c >> 1] = __builtin_amdgcn_cvt_pk_u8_f32(qa, 2 * (c & 1), w[c >> 1]); w[c >> 1] = __builtin_amdgcn_cvt_pk_u8_f32(qb, 2 * (c & 1) + 1, w[c >> 1]); }
                        *(GAS u32x4*)(GAB + ((size_t)row * 1024 + cb) * 2) = w; }
            }
        }
    }
    __device__ __forceinline__ void mid(f32x4 (&)[2][2][4][2], const GUnit&, int, int, int, int) const {}
};

__device__ __forceinline__ float ubf0(unsigned x) { return (float)(x & 0xffu); }
__device__ __forceinline__ float ubf1(unsigned x) { return (float)((x >> 8) & 0xffu); }
__device__ __forceinline__ float ubf2(unsigned x) { return (float)((x >> 16) & 0xffu); }
__device__ __forceinline__ float ubf3(unsigned x) { return (float)(x >> 24); }
struct EpiMerge {
    static constexpr bool SEG2 = true;
    const unsigned char* GAB; bf16_t* MG;
    __device__ __forceinline__ void mid(f32x4 (&acc)[2][2][4][2], const GUnit& u, int wr, int wc, int fr, int fq) const {
        const unsigned char* G_ = this->GAB; asm volatile("" : "+s"(G_)); const GAS unsigned char* G = (const GAS unsigned char*)G_;
        const int row0 = u.pm * 256 + wr * 64 + fr, col0 = u.pn * 256 + wc * 32 + 8 * fq;
#pragma unroll
        for (int ai = 0; ai < 2; ++ai) {
            u32x4 av[4][2];
#pragma unroll
            for (int m = 0; m < 4; ++m) { const unsigned ro = (unsigned)((row0 + ai * 128 + m * 16) * 1024 + col0) * 2u;
#pragma unroll
                for (int bj = 0; bj < 2; ++bj) av[m][bj] = *(const GAS u32x4*)(G + (ro + 256u * bj)); }
            __builtin_amdgcn_sched_barrier(0);
#pragma unroll
            for (int m = 0; m < 4; ++m)
#pragma unroll
                for (int bj = 0; bj < 2; ++bj) { const u32x4 a = av[m][bj];
#pragma unroll
                    for (int n = 0; n < 2; ++n) {
                        const f32x4 r = {ubf0(a[2 * n]) * fast_rcp(ubf1(a[2 * n])), ubf2(a[2 * n]) * fast_rcp(ubf3(a[2 * n])),
                                         ubf0(a[2 * n + 1]) * fast_rcp(ubf1(a[2 * n + 1])), ubf2(a[2 * n + 1]) * fast_rcp(ubf3(a[2 * n + 1]))};
                        acc[ai][bj][m][n] *= r; } }
        }
    }
    __device__ __forceinline__ void operator()(f32x4 (&acc)[2][2][4][2], const GUnit& u, int wr, int wc, int fr, int fq) const {
        const unsigned char* G_ = this->GAB; bf16_t* MG_ = this->MG; asm volatile("" : "+s"(G_), "+s"(MG_)); const GAS unsigned char* G = (const GAS unsigned char*)G_; GAS bf16_t* MG = (GAS bf16_t*)MG_;
        const int row0 = u.pm * 256 + wr * 64 + fr, col0 = u.pn * 256 + wc * 32 + 8 * fq;
        u32x4 bv[2][4][2];
#pragma unroll
        for (int ai = 0; ai < 2; ++ai)
#pragma unroll
            for (int m = 0; m < 4; ++m) { const unsigned ro = (unsigned)((row0 + ai * 128 + m * 16) * 1024 + col0) * 2u;
#pragma unroll
                for (int bj = 0; bj < 2; ++bj) bv[ai][m][bj] = *(const GAS u32x4*)(G + (ro + 256u * bj)); }
        __builtin_amdgcn_sched_barrier(0);
        constexpr float K255 = 1.0f / 255.0f;
#pragma unroll
        for (int ai = 0; ai < 2; ++ai)
#pragma unroll
            for (int m = 0; m < 4; ++m) { const unsigned ro = (unsigned)((row0 + ai * 128 + m * 16) * 1024 + col0) * 2u;
#pragma unroll
                for (int bj = 0; bj < 2; ++bj) { const u32x4 b = bv[ai][m][bj];
                    const f32x4 x0 = acc[ai][bj][m][0] * K255, x1 = acc[ai][bj][m][1] * K255;
                    const u32x4 ww = {cvtpk(x0[0] * ubf1(b[0]), x0[1] * ubf3(b[0])), cvtpk(x0[2] * ubf1(b[1]), x0[3] * ubf3(b[1])),
                                      cvtpk(x1[0] * ubf1(b[2]), x1[1] * ubf3(b[2])), cvtpk(x1[2] * ubf1(b[3]), x1[3] * ubf3(b[3]))};
                    *(GAS u32x4*)((GAS char*)MG + (ro + 256u * bj)) = ww; } }
    }
};

struct EpiX1 {
    static constexpr bool SEG2 = false;
    const float* X; bf16_t* X1B; float* SSQ; float* AMX;
    __device__ __forceinline__ void mid(f32x4 (&)[2][2][4][2], const GUnit&, int, int, int, int) const {}
    __device__ __forceinline__ void operator()(f32x4 (&acc)[2][2][4][2], const GUnit& u, int wr, int wc, int fr, int fq) const {
        const float* X_ = this->X; bf16_t* X1B_ = this->X1B; float* SSQ_ = this->SSQ; float* RM_ = this->AMX; asm volatile("" : "+s"(X_), "+s"(X1B_), "+s"(SSQ_), "+s"(RM_));
        const GAS char* X = (const GAS char*)X_; GAS char* X1B = (GAS char*)X1B_; GAS char* SSQ = (GAS char*)SSQ_; GAS char* AMX = (GAS char*)RM_;
        const int row0 = u.pm * 256 + wr * 64 + fr, col0 = u.pn * 256 + wc * 32 + 8 * fq;
        f32x4 xa[4][2][2], xb[4][2][2];
#pragma unroll
        for (int m = 0; m < 4; ++m) { const unsigned ro = (unsigned)((row0 + m * 16) * 1024 + col0) * 4u;
#pragma unroll
            for (int bj = 0; bj < 2; ++bj) { xa[m][bj][0] = *(const GAS f32x4*)(X + (ro + 512u * bj)); xa[m][bj][1] = *(const GAS f32x4*)(X + (ro + 512u * bj + 16u)); } }
        __builtin_amdgcn_sched_barrier(0);
        u32x4 pk[4][2]; float ssv[4], mxv[4];
#define X1_HALF(AI, XV) do { _Pragma("unroll") for (int m = 0; m < 4; ++m) { float ss = 0.f, mx = 0.f; \
            _Pragma("unroll") for (int bj = 0; bj < 2; ++bj) { const f32x4 v0 = XV[m][bj][0] + acc[AI][bj][m][0], v1 = XV[m][bj][1] + acc[AI][bj][m][1]; \
                ss += (v0[0] * v0[0] + v0[1] * v0[1]) + (v0[2] * v0[2] + v0[3] * v0[3]) + (v1[0] * v1[0] + v1[1] * v1[1]) + (v1[2] * v1[2] + v1[3] * v1[3]); \
                mx = fmaxf(fmaxf(fmaxf(fmaxf(mx, fabsf(v0[0])), fmaxf(fabsf(v0[1]), fabsf(v0[2]))), fmaxf(fmaxf(fabsf(v0[3]), fabsf(v1[0])), fmaxf(fabsf(v1[1]), fabsf(v1[2])))), fabsf(v1[3])); \
                pk[m][bj] = (u32x4){cvtpk(v0[0], v0[1]), cvtpk(v0[2], v0[3]), cvtpk(v1[0], v1[1]), cvtpk(v1[2], v1[3])}; } \
            ss += __shfl_xor(ss, 16); ss += __shfl_xor(ss, 32); mx = fmaxf(mx, __shfl_xor(mx, 16)); mx = fmaxf(mx, __shfl_xor(mx, 32)); ssv[m] = ss; mxv[m] = mx; } } while (0)
#define X1_STORE(AI) do { _Pragma("unroll") for (int m = 0; m < 4; ++m) { const int row = row0 + AI * 128 + m * 16; const unsigned ro = (unsigned)(row * 1024 + col0) * 2u; \
            _Pragma("unroll") for (int bj = 0; bj < 2; ++bj) *(GAS u32x4*)(X1B + (ro + 256u * bj)) = pk[m][bj]; \
            if (fq == 0) { const unsigned po = (unsigned)(row * 16 + 4 * u.pn + wc) * 4u; *(GAS float*)(SSQ + po) = ssv[m]; *(GAS float*)(AMX + po) = mxv[m]; } } } while (0)
        X1_HALF(0, xa);
        __builtin_amdgcn_sched_barrier(0);
#pragma unroll
        for (int m = 0; m < 4; ++m) { const unsigned ro = (unsigned)((row0 + 128 + m * 16) * 1024 + col0) * 4u;
#pragma unroll
            for (int bj = 0; bj < 2; ++bj) { xb[m][bj][0] = *(const GAS f32x4*)(X + (ro + 512u * bj)); xb[m][bj][1] = *(const GAS f32x4*)(X + (ro + 512u * bj + 16u)); } }
        __builtin_amdgcn_sched_barrier(0);
        X1_STORE(0);
        __builtin_amdgcn_sched_barrier(0);
        X1_HALF(1, xb);
        X1_STORE(1);
#undef X1_HALF
#undef X1_STORE
    }
};

struct EpiMoeUp {
    static constexpr bool SEG2 = false;
    const LAS int* tab; const int* lists; const float* rstd2; const u32x4* tok; bf16_t* HID; const float* SX1; const float* SWGU;
    __device__ __forceinline__ void mid(f32x4 (&)[2][2][4][2], const GUnit&, int, int, int, int) const {}
    __device__ __forceinline__ void operator()(f32x4 (&acc)[2][2][4][2], const GUnit& u, int wr, int wc, int fr, int fq) const {
        const int* lists_ = this->lists; const float* rstd2_ = this->rstd2; const u32x4* tok_ = this->tok; bf16_t* HID_ = this->HID; const float* SX_ = this->SX1; const float* SW_ = this->SWGU; asm volatile("" : "+s"(lists_), "+s"(rstd2_), "+s"(tok_), "+s"(HID_), "+s"(SX_), "+s"(SW_));
        const GAS int* lists = (const GAS int*)lists_; const GAS float* rstd2 = (const GAS float*)rstd2_; const GAS u32x4* tok = (const GAS u32x4*)tok_; GAS bf16_t* HID = (GAS bf16_t*)HID_; const GAS float* SX1 = (const GAS float*)SX_; const GAS float* SWGU = (const GAS float*)SW_;
        const int li = u.aux, slot = li & 1, n = tab[80 + li]; const GAS int* lp = lists + (size_t)li * LIST_CAP;
        const int r0 = u.pm * 256 + wr * 64 + fr, hc0 = 128 * u.pn + 32 * wc + 8 * fq;
        int tk[2][4];
#pragma unroll
        for (int ai = 0; ai < 2; ++ai)
#pragma unroll
            for (int m = 0; m < 4; ++m) { const int ridx = r0 + ai * 128 + m * 16; tk[ai][m] = lp[ridx < n ? ridx : n - 1]; }
        float rsv[2][4], wv[2][4];
#pragma unroll
        for (int ai = 0; ai < 2; ++ai)
#pragma unroll
            for (int m = 0; m < 4; ++m) { const GAS unsigned* tp = (const GAS unsigned*)tok + (size_t)tk[ai][m] * 4; rsv[ai][m] = __uint_as_float(tp[0]); wv[ai][m] = __uint_as_float(tp[2 + slot]); }
        f32x4 swg[2], swu[2];
        { const GAS float* swp = SWGU + (size_t)(li >> 1) * 1024 + 256 * u.pn + 32 * wc + 8 * fq;
#pragma unroll
          for (int nn = 0; nn < 2; ++nn) { swg[nn] = *(const GAS f32x4*)(swp + 4 * nn); swu[nn] = *(const GAS f32x4*)(swp + 128 + 4 * nn); } }
        asm volatile("" : "+v"(swg[0]), "+v"(swg[1]), "+v"(swu[0]), "+v"(swu[1]));
        asm volatile("" : "+v"(rsv[0][0]), "+v"(rsv[0][1]), "+v"(rsv[0][2]), "+v"(rsv[0][3]), "+v"(rsv[1][0]), "+v"(rsv[1][1]), "+v"(rsv[1][2]), "+v"(rsv[1][3]));
        asm volatile("" : "+v"(wv[0][0]), "+v"(wv[0][1]), "+v"(wv[0][2]), "+v"(wv[0][3]), "+v"(wv[1][0]), "+v"(wv[1][1]), "+v"(wv[1][2]), "+v"(wv[1][3]));
#pragma unroll
        for (int ai = 0; ai < 2; ++ai)
#pragma unroll
            for (int m = 0; m < 4; ++m) { const int ridx = r0 + ai * 128 + m * 16;
                if (ridx < n) { const int t = tk[ai][m]; const float rs = rsv[ai][m], w = wv[ai][m];
                    f32x4 h0, h1;
#pragma unroll
                    for (int i = 0; i < 4; ++i) { const float g0 = (float)__float_as_int(acc[ai][0][m][0][i]) * (rs * swg[0][i]), u0 = (float)__float_as_int(acc[ai][1][m][0][i]) * (rs * swu[0][i]), g1 = (float)__float_as_int(acc[ai][0][m][1][i]) * (rs * swg[1][i]), u1 = (float)__float_as_int(acc[ai][1][m][1][i]) * (rs * swu[1][i]);
                        h0[i] = siluf_(g0) * u0 * w; h1[i] = siluf_(g1) * u1 * w; }
                    const u32x4 ww = {cvtpk(h0[0], h0[1]), cvtpk(h0[2], h0[3]), cvtpk(h1[0], h1[1]), cvtpk(h1[2], h1[3])};
                    *(GAS u32x4*)(HID + ((size_t)slot * MTOK + t) * 512 + hc0) = ww; } }
    }
};
template <int SLOT> struct EpiMoeDown {
    static constexpr bool SEG2 = false;
    const LAS int* tab; const int* lists; float* OUT; bf16_t* Y0; const bf16_t* X1B;
    __device__ __forceinline__ void mid(f32x4 (&)[2][2][4][2], const GUnit&, int, int, int, int) const {}
    __device__ __forceinline__ void operator()(f32x4 (&acc)[2][2][4][2], const GUnit& u, int wr, int wc, int fr, int fq) const {
        const int* lists_ = this->lists; float* OUT_ = this->OUT; bf16_t* Y0_ = this->Y0; const bf16_t* X1B_ = this->X1B; asm volatile("" : "+s"(lists_), "+s"(OUT_), "+s"(Y0_), "+s"(X1B_));
        const GAS int* lists = (const GAS int*)lists_; GAS float* OUT = (GAS float*)OUT_; GAS bf16_t* Y0 = (GAS bf16_t*)Y0_; const GAS bf16_t* X1B = (const GAS bf16_t*)X1B_;
        const int li = u.aux, n = tab[80 + li]; const GAS int* lp = lists + (size_t)li * LIST_CAP;
        const int r0 = u.pm * 256 + wr * 64 + fr, col0 = 256 * u.pn + 32 * wc + 8 * fq;
        int tk[2][4];
#pragma unroll
        for (int ai = 0; ai < 2; ++ai)
#pragma unroll
            for (int m = 0; m < 4; ++m) { const int ridx = r0 + ai * 128 + m * 16; tk[ai][m] = lp[ridx < n ? ridx : n - 1]; }
        asm volatile("" : "+v"(tk[0][0]), "+v"(tk[0][1]), "+v"(tk[0][2]), "+v"(tk[0][3]), "+v"(tk[1][0]), "+v"(tk[1][1]), "+v"(tk[1][2]), "+v"(tk[1][3]));
        if (SLOT == 0) {
#pragma unroll
            for (int ai = 0; ai < 2; ++ai)
#pragma unroll
                for (int m = 0; m < 4; ++m) { const int ridx = r0 + ai * 128 + m * 16;
                    if (ridx < n) { GAS bf16_t* yp = Y0 + (size_t)tk[ai][m] * Y0_PITCH + col0;
#pragma unroll
                        for (int bj = 0; bj < 2; ++bj) { const f32x4 x0 = acc[ai][bj][m][0], x1 = acc[ai][bj][m][1];
                            const u32x4 ww = {cvtpk(x0[0], x0[1]), cvtpk(x0[2], x0[3]), cvtpk(x1[0], x1[1]), cvtpk(x1[2], x1[3])}; *(GAS u32x4*)(yp + 128 * bj) = ww; } } }
        } else {
#pragma unroll
            for (int ai = 0; ai < 2; ++ai)
#pragma unroll
                for (int mp = 0; mp < 2; ++mp) {
                    u32x4 av[2][2], yv[2][2];
#pragma unroll
                    for (int mm = 0; mm < 2; ++mm) { const int m = 2 * mp + mm; const GAS bf16_t* xp = X1B + (size_t)tk[ai][m] * 1024 + col0; const GAS bf16_t* yp = Y0 + (size_t)tk[ai][m] * Y0_PITCH + col0;
#pragma unroll
                        for (int bj = 0; bj < 2; ++bj) { av[mm][bj] = *(const GAS u32x4*)(xp + 128 * bj); yv[mm][bj] = *(const GAS u32x4*)(yp + 128 * bj); } }
                    __builtin_amdgcn_sched_barrier(0);
#pragma unroll
                    for (int mm = 0; mm < 2; ++mm) { const int m = 2 * mp + mm; const int ridx = r0 + ai * 128 + m * 16;
                        if (ridx < n) { GAS float* op = OUT + (size_t)tk[ai][m] * 1024 + col0;
#pragma unroll
                            for (int bj = 0; bj < 2; ++bj) { const u32x4 y = yv[mm][bj], xx = av[mm][bj];
                                const f32x4 y0 = {bf_lo(y[0]) + bf_lo(xx[0]), bf_hi(y[0]) + bf_hi(xx[0]), bf_lo(y[1]) + bf_lo(xx[1]), bf_hi(y[1]) + bf_hi(xx[1])};
                                const f32x4 y1 = {bf_lo(y[2]) + bf_lo(xx[2]), bf_hi(y[2]) + bf_hi(xx[2]), bf_lo(y[3]) + bf_lo(xx[3]), bf_hi(y[3]) + bf_hi(xx[3])};
                                *(GAS f32x4*)(op + 128 * bj) = y0 + acc[ai][bj][m][0]; *(GAS f32x4*)(op + 128 * bj + 4) = y1 + acc[ai][bj][m][1]; } } }
                }
        }
    }
};

struct EpiMoeDown2 {
    static constexpr bool SEG2 = true;
    const LAS int* tab; const unsigned* plist; float* OUT; const bf16_t* X1B;
    __device__ __forceinline__ void mid(f32x4 (&)[2][2][4][2], const GUnit&, int, int, int, int) const {}
    __device__ __forceinline__ void operator()(f32x4 (&acc)[2][2][4][2], const GUnit& u, int wr, int wc, int fr, int fq) const {
        const unsigned* pl_ = this->plist; float* OUT_ = this->OUT; const bf16_t* X1B_ = this->X1B; asm volatile("" : "+s"(pl_), "+s"(OUT_), "+s"(X1B_));
        const GAS unsigned* lp = (const GAS unsigned*)pl_ + (size_t)u.aux * LIST_CAP; GAS char* OUT = (GAS char*)OUT_; const GAS char* X1B = (const GAS char*)X1B_;
        const int n = tab[PairOrder::CNT0 + u.aux];
        const int r0 = u.pm * 256 + wr * 64 + fr, col0 = 256 * u.pn + 32 * wc + 8 * fq;
        unsigned ro[2][4];
#pragma unroll
        for (int ai = 0; ai < 2; ++ai)
#pragma unroll
            for (int m = 0; m < 4; ++m) { const int ridx = r0 + ai * 128 + m * 16; const unsigned tk = lp[ridx < n ? ridx : n - 1] & 0x7fffffffu; ro[ai][m] = (tk * 1024u + (unsigned)col0) * 2u; }
        asm volatile("" : "+v"(ro[0][0]), "+v"(ro[0][1]), "+v"(ro[0][2]), "+v"(ro[0][3]), "+v"(ro[1][0]), "+v"(ro[1][1]), "+v"(ro[1][2]), "+v"(ro[1][3]));
        u32x4 xa[4][2], xb[4][2];
#pragma unroll
        for (int m = 0; m < 4; ++m)
#pragma unroll
            for (int bj = 0; bj < 2; ++bj) xa[m][bj] = *(const GAS u32x4*)(X1B + (ro[0][m] + 256u * bj));
        __builtin_amdgcn_sched_barrier(0);
#pragma unroll
        for (int m = 0; m < 4; ++m)
#pragma unroll
            for (int bj = 0; bj < 2; ++bj) xb[m][bj] = *(const GAS u32x4*)(X1B + (ro[1][m] + 256u * bj));
        __builtin_amdgcn_sched_barrier(0);
#define MD2_HALF(AI, XV) do { _Pragma("unroll") for (int m = 0; m < 4; ++m) { const int ridx = r0 + AI * 128 + m * 16; \
            if (ridx < n) { _Pragma("unroll") for (int bj = 0; bj < 2; ++bj) { const u32x4 xx = XV[m][bj]; GAS char* op = OUT + ((size_t)ro[AI][m] * 2 + 512u * bj); \
                *(GAS f32x4*)op = (f32x4){bf_lo(xx[0]), bf_hi(xx[0]), bf_lo(xx[1]), bf_hi(xx[1])} + acc[AI][bj][m][0]; \
                *(GAS f32x4*)(op + 16) = (f32x4){bf_lo(xx[2]), bf_hi(xx[2]), bf_lo(xx[3]), bf_hi(xx[3])} + acc[AI][bj][m][1]; } } } } while (0)
        MD2_HALF(0, xa);
        MD2_HALF(1, xb);
#undef MD2_HALF
    }
};
namespace hg {
constexpr int TILE = 8192, BUF = 3 * TILE + 1024, NBUF = 3, GRP = NBUF * BUF;
static_assert(2 * GRP <= SCAN_LDS_BYTES, "scan ring fits below the LDS control words");
__device__ __forceinline__ unsigned off_b(unsigned row, unsigned ch) { return 256u * row + 16u * (ch ^ (((row & 3) << 2) | ((row >> 2) & 3))); }
__device__ __forceinline__ int crow(int r, int h) { return (r & 3) + 8 * (r >> 2) + 4 * h; }
__device__ __forceinline__ s16x4 trr(const LAS unsigned char* p) { typedef short v4i16 __attribute__((ext_vector_type(4))); return __builtin_bit_cast(s16x4, __builtin_amdgcn_ds_read_tr16_b64_v4i16((LAS v4i16*)p)); }
__device__ __forceinline__ bf16x8 pack8n(const f32x16& x, int s) {
    u32x4 p; p.x = cvtpk(x[8 * s], x[8 * s + 1]); p.y = cvtpk(x[8 * s + 2], x[8 * s + 3]); p.z = cvtpk(x[8 * s + 4], x[8 * s + 5]); p.w = cvtpk(x[8 * s + 6], x[8 * s + 7]);
    return __builtin_bit_cast(bf16x8, p);
}

__device__ __forceinline__ void hgrn_pair(int b, int head, LAS unsigned char* lds, const unsigned char* ws, int wave) {
    int tid_ = wave * 64 + mk_lane(); asm volatile("" : "+v"(tid_));
    const int tid = tid_, lane = tid & 63, r32 = lane & 31, h = lane >> 5; const int wid = __builtin_amdgcn_readfirstlane(tid >> 6);
    const int grp = wid >> 2, w = wid & 3;
    LAS unsigned char* gbase = lds + grp * GRP;
    const bf16_t* QE = (const bf16_t*)(ws + (grp ? WS_QEB : WS_QEF)); const bf16_t* KE = (const bf16_t*)(ws + (grp ? WS_KEB : WS_KEF)); const bf16_t* VH = (const bf16_t*)(ws + WS_VH);
    bf16_t* OD = (bf16_t*)(ws + (grp ? WS_OB : WS_OF));
    const int prow = lane >> 4, pch = lane & 15;
    unsigned so[2];
#pragma unroll
    for (int k = 0; k < 2; ++k) { const int row = 4 * (w + 4 * k) + prow; const int ch = pch ^ (((row & 3) << 2) | ((row >> 2) & 3)); so[k] = (unsigned)(row * 1024 + ch * 16); }
    const size_t colb = (size_t)head * 128 * 2;
#define HG_G16(src_, dst_) do { unsigned keep_; asm volatile("s_mov_b32 %0, m0\n\ts_mov_b32 m0, %2\n\ts_nop 0\n\tglobal_load_lds_dwordx4 %1, off\n\ts_mov_b32 m0, %0" : "=&s"(keep_) : "v"(src_), "s"((unsigned)__builtin_amdgcn_readfirstlane((int)(dst_))) : "memory"); } while (0)
#define HG_G4(src_, dst_) do { unsigned keep_; asm volatile("s_mov_b32 %0, m0\n\ts_mov_b32 m0, %2\n\ts_nop 0\n\tglobal_load_lds_dword %1, off\n\ts_mov_b32 m0, %0" : "=&s"(keep_) : "v"(src_), "s"((unsigned)__builtin_amdgcn_readfirstlane((int)(dst_))) : "memory"); } while (0)
    const unsigned gbase_u = (unsigned)(uintptr_t)gbase;
#define HG_DMA(st_, bi_) do { const int n_ = grp ? 255 - (st_) : (st_); const size_t tb_ = ((size_t)(b * SEQ + n_ * 32) * 512) * 2 + colb; const unsigned bb_ = gbase_u + (unsigned)(bi_); \
        _Pragma("unroll") for (int k_ = 0; k_ < 2; ++k_) { \
            HG_G16((const char*)QE + tb_ + so[k_], bb_ + 0 * TILE + (w + 4 * k_) * 1024); \
            HG_G16((const char*)KE + tb_ + so[k_], bb_ + 1 * TILE + (w + 4 * k_) * 1024); \
            HG_G16((const char*)VH + tb_ + so[k_], bb_ + 2 * TILE + (w + 4 * k_) * 1024); } \
        if (w < 2) { const float* vsrc_ = CV + (size_t)(b * 256 + n_) * 512 + head * 128 + w * 64 + lane; \
          HG_G4(vsrc_, bb_ + 3 * TILE + w * 256); } } while (0)
    const float* CV = (const float*)(ws + WS_CVEC) + (size_t)grp * 2048 * 512;
    { float* CW = (float*)(ws + WS_CVEC); const float* V4 = (const float*)(ws + WS_VEC);
      for (int idx = tid; idx < 2 * 256 * 128; idx += NWAVES * 64) { const int dir = idx >> 15, n_ = (idx >> 7) & 255, ch = idx & 127;
          const int chunk = dir ? 255 - n_ : n_, prev = dir ? chunk + 1 : chunk - 1; const size_t col = (size_t)head * 128 + ch;
          const float e = V4[((size_t)(dir ? 2 : 0) * 2048 + b * 256 + chunk) * 512 + col];
          const float g = (n_ > 0) ? V4[((size_t)(dir ? 3 : 1) * 2048 + b * 256 + prev) * 512 + col] : 1.0f;
          CW[((size_t)dir * 2048 + b * 256 + chunk) * 512 + col] = e * g; }
      asm volatile("s_waitcnt vmcnt(0)" ::: "memory"); __syncthreads(); __builtin_amdgcn_fence(__ATOMIC_ACQUIRE, "agent"); asm volatile("s_waitcnt vmcnt(0)" ::: "memory"); __syncthreads(); }
    f32x16 S[4];
#pragma unroll
    for (int T = 0; T < 4; ++T)
#pragma unroll
        for (int r = 0; r < 16; ++r) S[T][r] = 0.f;
    const int q4 = (lane & 15) >> 2, p4 = lane & 3, blk = (lane >> 4) & 1;
    int o_cur = 0, o_nxt = BUF, o_nn = 2 * BUF;
    HG_DMA(0, 0); HG_DMA(1, BUF);
    asm volatile("s_waitcnt vmcnt(6)" ::: "memory"); __builtin_amdgcn_s_barrier(); asm volatile("" ::: "memory");
    for (int st = 0; st < 256; ++st) {
        const int n = grp ? 255 - st : st;
        if (st + 2 < 256) HG_DMA(st + 2, o_nn);
        const LAS unsigned char* bb = gbase + o_cur;
        const LAS unsigned char* qe = bb; const LAS unsigned char* ke = bb + TILE; const LAS unsigned char* vv = bb + 2 * TILE;
        const LAS float* er = (const LAS float*)(bb + 3 * TILE);
        bf16x8 vf[2];
#pragma unroll
        for (int s = 0; s < 2; ++s) { const s16x4 lo = trr(vv + off_b(16 * s + 4 * h + q4, 4 * w + 2 * blk + (p4 >> 1)) + 8 * (p4 & 1)), hi = trr(vv + off_b(16 * s + 8 + 4 * h + q4, 4 * w + 2 * blk + (p4 >> 1)) + 8 * (p4 & 1));
            vf[s] = __builtin_shufflevector(lo, hi, 0, 1, 2, 3, 4, 5, 6, 7); }
#pragma unroll
        for (int T = 0; T < 4; ++T)
#pragma unroll
            for (int gq = 0; gq < 4; ++gq) { const f32x4 cc = *(const LAS f32x4*)(er + 32 * T + 8 * gq + 4 * h);
#pragma unroll
                for (int j = 0; j < 4; ++j) S[T][4 * gq + j] *= cc[j]; }
        f32x16 O;
#pragma unroll
        for (int r = 0; r < 16; ++r) O[r] = 0.f;
#pragma unroll
        for (int T = 0; T < 4; ++T)
#pragma unroll
            for (int s = 0; s < 2; ++s) {
                const bf16x8 sb = pack8n(S[T], s);
                const s16x4 a0 = *(const LAS s16x4*)(qe + off_b(r32, 4 * T + 2 * s) + 8 * h), a1 = *(const LAS s16x4*)(qe + off_b(r32, 4 * T + 2 * s + 1) + 8 * h);
                const bf16x8 af = __builtin_shufflevector(a0, a1, 0, 1, 2, 3, 4, 5, 6, 7);
                O = __builtin_amdgcn_mfma_f32_32x32x16_bf16(af, sb, O, 0, 0, 0);
            }
        f32x16 at;
#pragma unroll
        for (int r = 0; r < 16; ++r) at[r] = 0.f;
#pragma unroll
        for (int kk = 0; kk < 8; ++kk) { const bf16x8 ka = *(const LAS bf16x8*)(ke + off_b(r32, 2 * kk + h)), qb = *(const LAS bf16x8*)(qe + off_b(r32, 2 * kk + h));
            at = __builtin_amdgcn_mfma_f32_32x32x16_bf16(ka, qb, at, 0, 0, 0); }
#pragma unroll
        for (int r = 0; r < 16; ++r) { const int srow = crow(r, h); const bool keepv = grp ? (srow >= r32) : (srow <= r32); at[r] = keepv ? at[r] : 0.f; }
#pragma unroll
        for (int s = 0; s < 2; ++s) { const bf16x8 af = pack8n(at, s); O = __builtin_amdgcn_mfma_f32_32x32x16_bf16(af, vf[s], O, 0, 0, 0); }
#pragma unroll
        for (int T = 0; T < 4; ++T) {
#pragma unroll
            for (int s = 0; s < 2; ++s) { const s16x4 lo = trr(ke + off_b(16 * s + 4 * h + q4, 4 * T + 2 * blk + (p4 >> 1)) + 8 * (p4 & 1)), hi = trr(ke + off_b(16 * s + 8 + 4 * h + q4, 4 * T + 2 * blk + (p4 >> 1)) + 8 * (p4 & 1));
                const bf16x8 kf = __builtin_shufflevector(lo, hi, 0, 1, 2, 3, 4, 5, 6, 7);
                S[T] = __builtin_amdgcn_mfma_f32_32x32x16_bf16(kf, vf[s], S[T], 0, 0, 0); }
        }
        { bf16_t* op = OD + ((size_t)(b * SEQ + n * 32) * 512 + head * 128 + 32 * w + r32);
#pragma unroll
          for (int r = 0; r < 16; ++r) { const unsigned pk = cvtpk(O[r], 0.f); op[(size_t)crow(r, h) * 512] = (bf16_t)(pk & 0xffffu); } }
        if (st + 2 < 256) asm volatile("s_waitcnt vmcnt(22) lgkmcnt(0)" ::: "memory"); else asm volatile("s_waitcnt vmcnt(16) lgkmcnt(0)" ::: "memory");
        __builtin_amdgcn_s_barrier(); asm volatile("" ::: "memory");
        { const int t_ = o_cur; o_cur = o_nxt; o_nxt = o_nn; o_nn = t_; }
    }
    asm volatile("s_waitcnt vmcnt(0)" ::: "memory");
#undef HG_DMA
#undef HG_G16
#undef HG_G4
}
}

__device__ __forceinline__ void hgrn_finalize_bh(int b, int head, int row_lo, int row_hi, int wave, const unsigned char* ws) {
    const int lane = mk_lane(), sub = lane >> 4, l16 = lane & 15;
    const GAS bf16_t* OFW = (const GAS bf16_t*)(ws + WS_OF); const GAS bf16_t* OBW = (const GAS bf16_t*)(ws + WS_OB); GAS bf16_t* OG = (GAS bf16_t*)(ws + WS_OG);
    for (int r0 = row_lo + wave * 4; r0 < row_hi; r0 += NWAVES * 4) {
        const size_t o = ((size_t)b * SEQ + r0 + sub) * 512 + head * 128 + l16 * 8;
        const u32x4 a = *(const GAS u32x4*)(OFW + o), bb = *(const GAS u32x4*)(OBW + o), g = *(const GAS u32x4*)(OG + o);
        float v[8]; float ss = 0.f;
#pragma unroll
        for (int i = 0; i < 4; ++i) { v[2 * i] = bf_lo(a[i]) + bf_lo(bb[i]); v[2 * i + 1] = bf_hi(a[i]) + bf_hi(bb[i]); ss += v[2 * i] * v[2 * i] + v[2 * i + 1] * v[2 * i + 1]; }
        ss += __shfl_xor(ss, 1); ss += __shfl_xor(ss, 2); ss += __shfl_xor(ss, 4); ss += __shfl_xor(ss, 8);
        const float rn = 1.0f / sqrtf(ss * (1.0f / 128.0f) + EPS);
        u32x4 w;
#pragma unroll
        for (int i = 0; i < 4; ++i) { const float g0 = bf_lo(g[i]), g1 = bf_hi(g[i]); w[i] = cvtpk(v[2 * i] * rn * siluf_(g0), v[2 * i + 1] * rn * siluf_(g1)); }
        *(GAS u32x4*)(OG + o) = w;
    }
}

__device__ __forceinline__ void router_phase(Frame& F, int g0, int g1) {
    const int lane = mk_lane();
    LAS float* scr = (LAS float*)(F.lds + RING_OFF + F.wave * 4096);
    const bf16_t* X1 = (const bf16_t*)(F.ws + WS_X1B); const bf16_t* Wr = (const bf16_t*)(F.ws + WS_WR); const float* SSQ = (const float*)(F.ws + WS_SSQ);
    float* rstd2 = (float*)(F.ws + WS_RSTD2); u32x4* tokv = (u32x4*)(F.ws + WS_TOK); int* lists = (int*)(F.ws + WS_LIST);
    const float* brg = F.in[13]; const float* bre = F.in[15];
    float* sx1 = (float*)(F.ws + WS_SX1); unsigned char* X1Q = F.ws + WS_X1Q; const float* AMX = (const float*)(F.ws + WS_AMX);
    const int li = lane & 15, kq = lane >> 4;
    for (int grp = g0 + F.wave; grp < g1; grp += NWAVES) {
        const int tok0 = grp * 16;
        unsigned char* qrow = X1Q + (size_t)(tok0 + li) * 1024 + 8 * kq;
        const bf16_t* xr = X1 + (size_t)(tok0 + li) * 1024 + 8 * kq;
        const bf16_t* wr0 = Wr + (size_t)li * 1024 + 8 * kq;
        f32x4 acc[3];
#pragma unroll
        for (int t = 0; t < 3; ++t) acc[t] = (f32x4){0.f, 0.f, 0.f, 0.f};
        float mx; { const f32x4 am = *(const f32x4*)(AMX + (size_t)(tok0 + li) * 16 + 4 * kq); mx = fmaxf(fmaxf(am[0], am[1]), fmaxf(am[2], am[3])); }
        mx = fmaxf(mx, __shfl_xor(mx, 16)); mx = fmaxf(mx, __shfl_xor(mx, 32));
        const float amax = fmaxf(mx, 1e-30f), qs = 127.0f / amax;
#pragma unroll 4
        for (int kk = 0; kk < 32; ++kk) {
            const bf16x8 xa = *(const bf16x8*)(xr + 32 * kk);
            { const u32x4 xw = __builtin_bit_cast(u32x4, xa); unsigned q0 = 0u, q1 = 0u;
              q0 = __builtin_amdgcn_cvt_pk_u8_f32(rintf(bf_lo(xw[0]) * qs) + 128.0f, 0, q0); q0 = __builtin_amdgcn_cvt_pk_u8_f32(rintf(bf_hi(xw[0]) * qs) + 128.0f, 1, q0);
              q0 = __builtin_amdgcn_cvt_pk_u8_f32(rintf(bf_lo(xw[1]) * qs) + 128.0f, 2, q0); q0 = __builtin_amdgcn_cvt_pk_u8_f32(rintf(bf_hi(xw[1]) * qs) + 128.0f, 3, q0);
              q1 = __builtin_amdgcn_cvt_pk_u8_f32(rintf(bf_lo(xw[2]) * qs) + 128.0f, 0, q1); q1 = __builtin_amdgcn_cvt_pk_u8_f32(rintf(bf_hi(xw[2]) * qs) + 128.0f, 1, q1);
              q1 = __builtin_amdgcn_cvt_pk_u8_f32(rintf(bf_lo(xw[3]) * qs) + 128.0f, 2, q1); q1 = __builtin_amdgcn_cvt_pk_u8_f32(rintf(bf_hi(xw[3]) * qs) + 128.0f, 3, q1);
              *(u32x2*)(qrow + 32 * kk) = (u32x2){q0 ^ 0x80808080u, q1 ^ 0x80808080u}; }
#pragma unroll
            for (int t = 0; t < 3; ++t) { const bf16x8 wh = *(const bf16x8*)(wr0 + (size_t)16 * t * 1024 + 32 * kk), wl = *(const bf16x8*)(wr0 + (size_t)(48 + 16 * t) * 1024 + 32 * kk);
                acc[t] = __builtin_amdgcn_mfma_f32_16x16x32_bf16(xa, wh, acc[t], 0, 0, 0); acc[t] = __builtin_amdgcn_mfma_f32_16x16x32_bf16(xa, wl, acc[t], 0, 0, 0); }
        }
#pragma unroll
        for (int t = 0; t < 3; ++t)
#pragma unroll
            for (int r = 0; r < 4; ++r) scr[(4 * kq + r) * 48 + 16 * t + li] = acc[t][r];
        LDS_WAIT(); asm volatile("" ::: "memory");
        if (lane < 16) {
            const int tk = tok0 + lane; const float* sp = SSQ + (size_t)tk * 16; float ss = 0.f;
#pragma unroll
            for (int i = 0; i < 4; ++i) { const f32x4 q = *(const f32x4*)(sp + 4 * i); ss += (q[0] + q[1]) + (q[2] + q[3]); }
            const float rs = 1.0f / sqrtf(ss * (1.0f / 1024.0f) + EPS);
            rstd2[tk] = rs; sx1[tk] = amax * (1.0f / 127.0f);
            const LAS float* lg = scr + lane * 48;
            float gl[4]; float gm = -3.0e38f; int gi = 0;
#pragma unroll
            for (int j = 0; j < 4; ++j) { gl[j] = lg[j] * rs + brg[j]; if (gl[j] > gm) { gm = gl[j]; gi = j; } }
            float gz = 0.f;
#pragma unroll
            for (int j = 0; j < 4; ++j) gz += expf(gl[j] - gm);
            const float pg = 1.0f / gz;
            float el[8]; float m0 = -3.0e38f; int i0 = 0;
#pragma unroll
            for (int j = 0; j < 8; ++j) { el[j] = lg[4 + 8 * gi + j] * rs + bre[8 * gi + j]; if (el[j] > m0) { m0 = el[j]; i0 = j; } }
            float m1 = -3.0e38f; int i1 = 0;
#pragma unroll
            for (int j = 0; j < 8; ++j) { if (j != i0 && el[j] > m1) { m1 = el[j]; i1 = j; } }
            const float p1 = expf(m1 - m0);
            const float w0 = pg / (1.0f + p1), w1 = pg * p1 / (1.0f + p1);
            const int e0 = 8 * gi + i0, e1 = 8 * gi + i1;
            tokv[tk] = (u32x4){__float_as_uint(rs * amax * (1.0f / 127.0f)), (unsigned)(e0 | (e1 << 8)), __float_as_uint(w0), __float_as_uint(w1)};
            const unsigned pos0 = __hip_atomic_fetch_add((unsigned*)(F.ctl + CW_CNT + 64 * (2 * e0)), 1u, RLX_AGENT);
            lists[(size_t)(2 * e0) * LIST_CAP + pos0] = tk;
            const unsigned pos1 = __hip_atomic_fetch_add((unsigned*)(F.ctl + CW_CNT + 64 * (2 * e1 + 1)), 1u, RLX_AGENT);
            lists[(size_t)(2 * e1 + 1) * LIST_CAP + pos1] = tk;
            { const int a = i0 < i1 ? i0 : i1, b = i0 < i1 ? i1 : i0, pl = 28 * gi + (a * 8 - ((a * (a + 1)) >> 1)) + (b - a - 1);
              const unsigned pp = __hip_atomic_fetch_add((unsigned*)(F.ctl + CW_PCNT + 16 * pl), 1u, RLX_AGENT);
              ((unsigned*)(F.ws + WS_PLIST))[(size_t)pl * LIST_CAP + pp] = (unsigned)tk | (i0 > i1 ? 0x80000000u : 0u); }
        }
        LDS_WAIT(); asm volatile("" ::: "memory");
    }
}
#define MK_TID (F.wave * 64 + mk_lane())
#define MK_LEADER (F.wave == 0 && mk_lane() == 0)
struct Args { const float* in[19]; float* out; unsigned char* ws; };

__device__ __forceinline__ int wave_incl_scan(int v, int lane) {
#pragma unroll
    for (int o = 1; o < 64; o <<= 1) { const int t = __shfl_up(v, o); if (lane >= o) v += t; }
    return v;
}
__device__ __forceinline__ void moe_table(Frame& F, int nl, int lst0, int lstep) {
    LAS int* tab = (LAS int*)(F.lds + MOETAB_OFF);
    __syncthreads();
    if (F.wave == 0) { const int l = mk_lane();
        const int cnt = (int)__hip_atomic_load((unsigned*)(F.ctl + CW_CNT + 64 * l), RLX_AGENT); tab[80 + l] = cnt;
        const int li = lst0 + lstep * l; const int cj = (l < nl) ? __shfl(cnt, li & 63) : 0;
        const int t = (cj + 255) >> 8, s = wave_incl_scan(t, l);
        if (l < nl) tab[l] = s - t;
        if (l == 63) tab[nl] = s; }
    __syncthreads();
}

__device__ __forceinline__ void pair_table(Frame& F) {
    LAS int* tab = (LAS int*)(F.lds + MOETAB_OFF);
    __syncthreads();
    if (F.wave == 0) { const int l = mk_lane(); const bool v1 = (l + 64) < NPAIR;
        const int c0 = (int)__hip_atomic_load((unsigned*)(F.ctl + CW_PCNT + 16 * l), RLX_AGENT);
        const int c1 = v1 ? (int)__hip_atomic_load((unsigned*)(F.ctl + CW_PCNT + 16 * (l + 64)), RLX_AGENT) : 0;
        const int t0 = (c0 + 255) >> 8, t1 = (c1 + 255) >> 8;
        const int s0 = wave_incl_scan(t0, l), s1 = wave_incl_scan(t1, l), tot0 = __shfl(s0, 63), tot1 = __shfl(s1, 63);
        tab[l] = s0 - t0; tab[PairOrder::CNT0 + l] = c0;
        if (v1) { tab[64 + l] = tot0 + s1 - t1; tab[PairOrder::CNT0 + 64 + l] = c1; }
        if (l == 0) tab[NPAIR] = tot0 + tot1; }
    __syncthreads();
}

__global__ void __launch_bounds__(NWAVES * 64, 2) mk_fwd(Args args) {
    extern __shared__ __attribute__((aligned(16))) unsigned char lds[];
    Frame F;
    F.lds = (LAS unsigned char*)lds;
    F.MISC = (volatile LAS unsigned*)(F.lds + MISC_OFF);
    F.wave = __builtin_amdgcn_readfirstlane((int)threadIdx.x >> 6);

    F.G = gridDim.x; { const int bx = blockIdx.x; F.vcu = (F.G % 8 == 0) ? (bx % 8) * (F.G / 8) + bx / 8 : bx; }
    F.ws = args.ws; F.out = args.out; F.ctl = (gu32*)(args.ws + WS_CTL);
#pragma unroll
    for (int i = 0; i < 19; ++i) F.in[i] = args.in[i];
    for (int u = MK_TID; u < 2048 / 4; u += NWAVES * 64) ((LAS unsigned*)(F.lds + LDSCTL_OFF))[u] = 0u;
    __syncthreads();
    XcdBarrier bar = xcd_barrier_post((unsigned*)(F.ctl + CW_BAR), F.MISC + 8, MK_LEADER);
    unsigned char* ws = args.ws;
    const LAS int* tab = (const LAS int*)(F.lds + MOETAB_OFF);

    p0_prologue(F);
    xcd_barrier(bar, MK_LEADER);

    {
        DenseOrder S8; S8.T.init(MTOK / 256, 13, F.G, (int)blockIdx.x); S8.A = (const char*)(ws + WS_X0Q); S8.Bt = (const char*)(ws + WS_WINQ); S8.K = 512; S8.pn_split = 3; S8.pn_skip = 8;
        DenseOrder SQ; SQ.T.init(MTOK / 256, 8, F.G, (int)blockIdx.x); SQ.A = (const char*)(ws + WS_X0Q); SQ.Bt = (const char*)(ws + WS_WINQ); SQ.K = 512; SQ.pn_off = 3;
        { const u32x4* rsrc = (const u32x4*)(ws + WS_ROPE); LAS u32x4* rdst = (LAS u32x4*)(F.lds + ROPE_LDS_OFF); for (int i = MK_TID; i < 1024; i += NWAVES * 64) rdst[i] = rsrc[i];
          const u32x4* lsrc = (const u32x4*)(ws + WS_LBV); for (int i = MK_TID; i < 256; i += NWAVES * 64) rdst[1024 + i] = lsrc[i]; __syncthreads(); }
        EpiInProj<true, true> EQ; EQ.ws = ws; EQ.outb = (unsigned char*)F.out; EQ.ropeL = (const LAS f32x4*)(F.lds + ROPE_LDS_OFF);
        pg8::gemm_phase<EpiInProj<true, true>, DenseOrder, true, true>(F.lds + RING_OFF, F.wave, 512, SQ, EQ);
        __syncthreads();
        EpiInProj<true, false> E8; E8.ws = ws; E8.outb = (unsigned char*)F.out; E8.ropeL = (const LAS f32x4*)(F.lds + ROPE_LDS_OFF);
        pg8::gemm_phase<EpiInProj<true, false>, DenseOrder, true, true>(F.lds + RING_OFF, F.wave, 512, S8, E8);
    }
    xcd_barrier(bar, MK_LEADER);

    const float mbound = *(const float*)(ws + WS_QKN + 512);
    if (blockIdx.x < 32) {
        hg::hgrn_pair((int)blockIdx.x >> 2, (int)blockIdx.x & 3, F.lds + RING_OFF, ws, F.wave);
        __syncthreads();
        if (MK_LEADER) { __builtin_amdgcn_fence(__ATOMIC_RELEASE, "agent"); asm volatile("s_waitcnt vmcnt(0)" ::: "memory"); __hip_atomic_store((unsigned*)(F.ctl + CW_HFLAG + 64 * (int)blockIdx.x), 1u, RLX_AGENT); }
    }
    constexpr int NFIN = 256;
    const int myx = (int)(xb_xcc_id() & 7u);
    int vpre = -1; bool pf = false;
    for (;;) {
        __syncthreads();
        if (MK_TID == 0) {
            int code = -1; pf = false;
            unsigned v; if (vpre >= 0) { v = (unsigned)vpre; vpre = -1; } else v = __hip_atomic_fetch_add((unsigned*)(F.ctl + CW_QHEAD + 64 * myx), 1u, RLX_AGENT);
            if (v < 256u) { code = myx * 256 + (int)v; pf = v < 176u; }
            else {
                const unsigned f = __hip_atomic_fetch_add((unsigned*)(F.ctl + CW_QHEAD + 64 * 8), 1u, RLX_AGENT);
                if (f < (unsigned)NFIN) code = 2048 + (int)f;
                else for (int k = 1; k < 8 && code < 0; ++k) { const int y = (myx + k) & 7; v = __hip_atomic_fetch_add((unsigned*)(F.ctl + CW_QHEAD + 64 * y), 1u, RLX_AGENT); if (v < 256u) code = y * 256 + (int)v; }
            }
            F.MISC[12] = (unsigned)code;
        }
        __syncthreads();
        const int idx = (int)F.MISC[12];
        if (idx < 0) break;
        if (idx >= 2048) {
            const int f = idx - 2048, bh = f >> 3, sl = f & 7;
            if (F.wave == 0) {
                unsigned sp = 0; while (__builtin_amdgcn_readfirstlane((int)__hip_atomic_load((unsigned*)(F.ctl + CW_HFLAG + 64 * bh), RLX_AGENT)) == 0) { __builtin_amdgcn_s_sleep(8); if (++sp > (1u << 22)) break; }
                __builtin_amdgcn_fence(__ATOMIC_ACQUIRE, "agent"); asm volatile("s_waitcnt vmcnt(0)" ::: "memory");
            }
            __syncthreads();
            hgrn_finalize_bh(bh >> 2, bh & 3, sl * 1024, sl * 1024 + 1024, F.wave, ws);
            continue;
        }
        if (MK_TID == 0 && pf) vpre = (int)__hip_atomic_fetch_add((unsigned*)(F.ctl + CW_QHEAD + 64 * myx), 1u, RLX_AGENT);
        const int bkv = idx >> 7, r = idx & 127, b = bkv >> 1, hh = (bkv & 1) * 4 + (r >> 5), qb = r & 31;
        attn_body::attn_unit(b, hh, qb, (const attn_body::bf16*)(ws + WS_Q), (const attn_body::bf16*)(ws + WS_K), (const attn_body::bf16*)(ws + WS_V), (attn_body::bf16*)(ws + WS_Q), (char*)lds + RING_OFF, mbound, F.wave);
    }
    xcd_barrier(bar, MK_LEADER);
    {
        Seg2Order S; S.T.init(MTOK / 256, 4, F.G, (int)blockIdx.x); S.ws = (const char*)ws; S.K = 512;
        EpiMerge E; E.GAB = (const unsigned char*)F.out; E.MG = (bf16_t*)(ws + WS_MERGED);
        pg8::gemm_phase<EpiMerge, Seg2Order, true>(F.lds + RING_OFF, F.wave, 512, S, E);
    }
    xcd_barrier(bar, MK_LEADER);
    {
        DenseOrder S; S.T.init(MTOK / 256, 4, F.G, (int)blockIdx.x); S.A = (const char*)(ws + WS_MERGED); S.Bt = (const char*)(ws + WS_WOUT); S.K = 1024;
        EpiX1 E; E.X = F.in[0]; E.X1B = (bf16_t*)(ws + WS_X1B); E.SSQ = (float*)(ws + WS_SSQ); E.AMX = (float*)(ws + WS_AMX);
        pg8::gemm_phase<EpiX1, DenseOrder, true>(F.lds + RING_OFF, F.wave, 1024, S, E);
    }
    xcd_barrier(bar, MK_LEADER);
    for (int gb = F.vcu * 16; gb < MTOK / 16; gb += F.G * 16) router_phase(F, gb, gb + 16);
    xcd_barrier(bar, MK_LEADER);
    moe_table(F, 64, 0, 1);
    {
        MoeOrder S; S.tab = tab; S.nl = 64; S.lst0 = 0; S.lstep = 1; S.lists = (const int*)(ws + WS_LIST); S.A = (const char*)(ws + WS_X1Q); S.W = (const char*)(ws + WS_WGUQ); S.wstride = (size_t)1024 * 1024; S.K = 512; S.G = F.G; S.c = F.vcu;
        EpiMoeUp E; E.tab = tab; E.lists = (const int*)(ws + WS_LIST); E.rstd2 = (const float*)(ws + WS_RSTD2); E.tok = (const u32x4*)(ws + WS_TOK); E.HID = (bf16_t*)(ws + WS_HID); E.SX1 = (const float*)(ws + WS_SX1); E.SWGU = (const float*)(ws + WS_SWGU);
        pg8::gemm_phase<EpiMoeUp, MoeOrder, true, true>(F.lds + RING_OFF, F.wave, 512, S, E);
    }
    xcd_barrier(bar, MK_LEADER);
    {
        pair_table(F);
        PairOrder S; S.tab = tab; S.plist = (const unsigned*)(ws + WS_PLIST); S.HID = (const char*)(ws + WS_HID); S.W = (const char*)(ws + WS_WD); S.wstride = (size_t)1024 * 512 * 2; S.K = 512; S.G = F.G; S.c = F.vcu;
        EpiMoeDown2 E; E.tab = tab; E.plist = (const unsigned*)(ws + WS_PLIST); E.OUT = F.out; E.X1B = (const bf16_t*)(ws + WS_X1B);
        pg8::gemm_phase<EpiMoeDown2, PairOrder, true>(F.lds + RING_OFF, F.wave, 512, S, E);
    }
}

extern "C" void kernel_launch(void* const* d_in, const int* in_sizes, int n_in, void* d_out, int out_size, void* d_ws, size_t ws_size, hipStream_t stream) {
    static int grid = 0;
    if (grid == 0) {
        if (n_in != 19 || out_size != MTOK * DMODEL || ws_size < WS_END) { fprintf(stderr, "kernel_launch: built for 19 inputs, %d outputs, >= %zu bytes of workspace; got n_in %d, out %d, ws %zu; nothing launched\n", MTOK * DMODEL, (size_t)WS_END, n_in, out_size, ws_size); grid = -1; return; }
        int dev = 0, cus = 0, per_cu = 0;
        if (hipGetDevice(&dev) != hipSuccess || hipDeviceGetAttribute(&cus, hipDeviceAttributeMultiprocessorCount, dev) != hipSuccess) { grid = -1; return; }
        if (hipFuncSetAttribute((const void*)mk_fwd, hipFuncAttributeMaxDynamicSharedMemorySize, LDS_BYTES) != hipSuccess) { fprintf(stderr, "kernel_launch: hipFuncSetAttribute failed\n"); grid = -1; return; }
        if (hipOccupancyMaxActiveBlocksPerMultiprocessor(&per_cu, (const void*)mk_fwd, NWAVES * 64, LDS_BYTES) != hipSuccess || per_cu < 1) fprintf(stderr, "kernel_launch: occupancy query reports %d workgroups per CU\n", per_cu);
        (void)hipGetLastError();
        grid = cus;
    }
    if (grid < 0) return;
    if (hipMemsetAsync((char*)d_ws + WS_CTL, 0, CTL_ZERO_BYTES, stream) != hipSuccess) return;
    Args a{};
    for (int i = 0; i < 19; ++i) a.in[i] = (const float*)d_in[i];
    a.out = (float*)d_out; a.ws = (unsigned char*)d_ws;
    hipLaunchKernelGGL(mk_fwd, dim3(grid), dim3(NWAVES * 64), LDS_BYTES, stream, a);
}
```

```cpp
#include <hip/hip_runtime.h>
#include <hip/hip_bf16.h>
#include <cstdio>
#include <cstdint>
#include <cmath>

#define LAS __attribute__((address_space(3)))
#define GAS __attribute__((address_space(1)))
typedef unsigned short bf16_t;
typedef short bf16x8 __attribute__((ext_vector_type(8)));
typedef short s16x4 __attribute__((ext_vector_type(4)));
typedef float f32x4 __attribute__((ext_vector_type(4)));
typedef float f32x2 __attribute__((ext_vector_type(2)));
typedef float f32x16 __attribute__((ext_vector_type(16)));
typedef unsigned u32x4 __attribute__((ext_vector_type(4)));
typedef int i32x4 __attribute__((ext_vector_type(4)));
typedef unsigned u32x2 __attribute__((ext_vector_type(2)));
typedef __bf16 bf16x2_t __attribute__((ext_vector_type(2)));

__device__ __forceinline__ int mk_lane() { int l; asm volatile("v_mbcnt_lo_u32_b32 %0, -1, 0\n\tv_mbcnt_hi_u32_b32 %0, -1, %0" : "=v"(l)); return l; }
__device__ __forceinline__ unsigned cvtpk(float lo, float hi) { f32x2 v = {lo, hi}; bf16x2_t b = __builtin_convertvector(v, bf16x2_t); return __builtin_bit_cast(unsigned, b); }
__device__ __forceinline__ float bf_lo(unsigned w) { return __uint_as_float(w << 16); }
__device__ __forceinline__ float bf_hi(unsigned w) { return __uint_as_float(w & 0xffff0000u); }
__device__ __forceinline__ float fast_exp(float x) { return __builtin_amdgcn_exp2f(x * 1.4426950408889634f); }
__device__ __forceinline__ float fast_rcp(float x) { return __builtin_amdgcn_rcpf(x); }
__device__ __forceinline__ float sigmoidf_(float x) { return fast_rcp(1.0f + fast_exp(-x)); }
__device__ __forceinline__ float siluf_(float x) { return x * sigmoidf_(x); }

namespace pg8 {
constexpr int BM = 256, BK = 64, HALF = 128, HTB = HALF * BK * 2, STAGE_BYTES = 8 * HTB, NXCD = 8, WGM = 8;
__host__ __device__ __forceinline__ int lds_byte(int r, int c) { const int st = (r >> 4) * 2 + (c >> 5), rr = r & 15, cc = c & 31, ob = rr * 64 + cc * 2; return st * 1024 + (ob ^ (((ob >> 9) & 1) << 5)); }
__host__ __device__ __forceinline__ void stage_rc(int b, int& R, int& C) { const int st = b / 1024, sb = b % 1024, swz = sb ^ (((sb >> 9) & 1) << 5); R = (st >> 1) * 16 + swz / 64; C = (st & 1) * 32 + (swz % 64) / 2; }
__host__ __device__ __forceinline__ int perm32(int rho) { const int n = rho >> 4, i = rho & 15; return 8 * (i >> 2) + 4 * n + (i & 3); }

struct GUnit { int pm, pn; const char* Ab; const char* Bb; int seg; int aux; };

struct TileOrder {
    int nM, nN, nwg, G, c;
    __device__ void init(int nM_, int nN_, int G_, int c_) { nM = nM_; nN = nN_; nwg = nM * nN; G = G_; c = c_; }
    __device__ bool tile(int i, int& pm, int& pn) const {
        const long L = (long)i * G + c; if (L >= nwg) return false;
        int wgid = (int)L; { const int q = nwg / NXCD, r = nwg % NXCD, xcd = wgid % NXCD, off = wgid / NXCD; wgid = (xcd < r ? xcd * (q + 1) : r * (q + 1) + (xcd - r) * q) + off; }
        const int nig = WGM * nN, gid = wgid / nig, fm = gid * WGM, gsz = (nM - fm) < WGM ? (nM - fm) : WGM;
        pm = fm + ((wgid % nig) % gsz); pn = (wgid % nig) / gsz; return true;
    }
};

template <class Epi, class Sched, bool ALIGN_EPI, bool I8 = false>
__device__ __forceinline__ void gemm_phase(LAS unsigned char* lds, const int wave, const int K, const Sched& S, const Epi& E) {
    int tid_ = wave * 64 + mk_lane(); asm volatile("" : "+v"(tid_));
    const int tid = tid_, wid = __builtin_amdgcn_readfirstlane(tid >> 6), lane = tid & 63, wr = wid >> 2, wc = wid & 3, fr = lane & 15, fq = lane >> 4;
    const int nt = K / BK;
    int Rr[2], Cc[2]; unsigned voffB[2];
#pragma unroll
    for (int i = 0; i < 2; ++i) { int R, C; stage_rc(tid * 16 + i * 8192, R, C); Rr[i] = R; Cc[i] = C; const int Rb = (R & ~31) + perm32(R & 31); voffB[i] = (unsigned)(Rb * K + C) * 2u; }
    const unsigned kstep = (unsigned)(BK * 2);
    const size_t hstepB = (size_t)HALF * K * 2;
    const unsigned ldsw = (unsigned)wid * 1024u;
    const int aoff = lds_byte(wr * 64 + fr, fq * 8), boff = lds_byte(wc * 32 + fr, fq * 8);
#define PG8_SA(b, h) (((b) * 2 + (h)) * HTB)
#define PG8_SB(b, h) ((4 + (b) * 2 + (h)) * HTB)
#define PG8_STAGE_B(bufoff, gbase) do { _Pragma("unroll") for (int _i = 0; _i < 2; ++_i) \
        __builtin_amdgcn_global_load_lds((const unsigned*)((const char*)(gbase) + voffB[_i]), (LAS unsigned*)(lds + (bufoff) + ldsw + _i * 8192), 16, 0, 0); } while (0)
#define PG8_STAGE_A(bufoff, gbase, o0, o1) do { \
        __builtin_amdgcn_global_load_lds((const unsigned*)((const char*)(gbase) + (o0)), (LAS unsigned*)(lds + (bufoff) + ldsw), 16, 0, 0); \
        __builtin_amdgcn_global_load_lds((const unsigned*)((const char*)(gbase) + (o1)), (LAS unsigned*)(lds + (bufoff) + ldsw + 8192), 16, 0, 0); } while (0)
#define PG8_LDA(dst, b, h) do { _Pragma("unroll") for (int m = 0; m < 4; ++m) _Pragma("unroll") for (int k = 0; k < 2; ++k) dst[m][k] = *(const LAS bf16x8*)(lds + PG8_SA(b, h) + aoff + m * 2048 + k * 1024); } while (0)
#define PG8_LDB(dst, b, h) do { _Pragma("unroll") for (int n = 0; n < 2; ++n) _Pragma("unroll") for (int k = 0; k < 2; ++k) dst[n][k] = *(const LAS bf16x8*)(lds + PG8_SB(b, h) + boff + n * 2048 + k * 1024); } while (0)
#define PG8_MMA(ai, bj, At, Bt) do { __builtin_amdgcn_s_setprio(1); _Pragma("unroll") for (int m = 0; m < 4; ++m) _Pragma("unroll") for (int n = 0; n < 2; ++n) _Pragma("unroll") for (int k = 0; k < 2; ++k) { \
        if constexpr (I8) acc[ai][bj][m][n] = __builtin_bit_cast(f32x4, __builtin_amdgcn_mfma_i32_16x16x64_i8(__builtin_bit_cast(i32x4, Bt[n][k]), __builtin_bit_cast(i32x4, At[m][k]), __builtin_bit_cast(i32x4, acc[ai][bj][m][n]), 0, 0, 0)); \
        else acc[ai][bj][m][n] = __builtin_amdgcn_mfma_f32_16x16x32_bf16(Bt[n][k], At[m][k], acc[ai][bj][m][n], 0, 0, 0); } __builtin_amdgcn_s_setprio(0); } while (0)
#define PG8_WAIT_V(n) asm volatile("s_waitcnt vmcnt(" #n ")" ::: "memory")
#define PG8_WAIT_L(n) asm volatile("s_waitcnt lgkmcnt(" #n ")" ::: "memory")
#define PG8_BAR __builtin_amdgcn_s_barrier()
#define PG8_SCHED __builtin_amdgcn_sched_barrier(0)
    GUnit cur, nxt; int ui = 0;
    if (!S.next(0, cur)) return;
    unsigned ca[2][2], na[2][2];
    S.aoff(cur, Rr, Cc, ca);
    f32x4 acc[2][2][4][2];
#pragma unroll
    for (int a = 0; a < 2; ++a)
#pragma unroll
        for (int b = 0; b < 2; ++b)
#pragma unroll
            for (int m = 0; m < 4; ++m)
#pragma unroll
                for (int n = 0; n < 2; ++n) acc[a][b][m][n] = (f32x4){0.f, 0.f, 0.f, 0.f};
    bf16x8 At[4][2], B0[2][2], B1[2][2];
    const char* cA = cur.Ab; const char* cB = cur.Bb;
    PG8_STAGE_B(PG8_SB(0, 0), cB); PG8_STAGE_B(PG8_SB(0, 1), cB + hstepB); PG8_STAGE_A(PG8_SA(0, 0), cA, ca[0][0], ca[0][1]); PG8_STAGE_A(PG8_SA(0, 1), cA, ca[1][0], ca[1][1]);
    if (wr == 1) PG8_BAR;
    PG8_WAIT_V(2); PG8_BAR;
    PG8_STAGE_B(PG8_SB(1, 0), cB + kstep); PG8_STAGE_A(PG8_SA(1, 0), cA + kstep, ca[0][0], ca[0][1]); PG8_STAGE_B(PG8_SB(1, 1), cB + hstepB + kstep);
    PG8_WAIT_V(6); PG8_BAR;
    for (;;) {
        const bool has_next = S.next(ui + 1, nxt);
        if (has_next) S.aoff_raw(nxt, Rr, Cc, na);
        else {
#pragma unroll
            for (int h = 0; h < 2; ++h)
#pragma unroll
                for (int i = 0; i < 2; ++i) na[h][i] = ca[h][i];
        }
        const char* nA = has_next ? nxt.Ab : cA; const char* nB = has_next ? nxt.Bb : cB;
        for (int t = 0; t < nt; t += 2) {
            const bool last = (t == nt - 2);
            const char* a1 = cA + (size_t)(t + 1) * kstep;
            const char* a2 = last ? nA : cA + (size_t)(t + 2) * kstep; const char* b2 = last ? nB : cB + (size_t)(t + 2) * kstep;
            const char* a3 = a2 + kstep; const char* b3 = b2 + kstep;
            unsigned o00 = ca[0][0], o01 = ca[0][1], o10 = ca[1][0], o11 = ca[1][1];
            if (last) { if (has_next) S.aoff_fin(nxt, na, Cc); asm volatile("" : "+v"(na[0][0]), "+v"(na[0][1]), "+v"(na[1][0]), "+v"(na[1][1]));
                o00 = na[0][0]; o01 = na[0][1]; o10 = na[1][0]; o11 = na[1][1]; }
            PG8_LDB(B0, 0, 0); PG8_LDB(B1, 0, 1); PG8_SCHED; PG8_LDA(At, 0, 0); PG8_STAGE_A(PG8_SA(1, 1), a1, ca[1][0], ca[1][1]);
            PG8_WAIT_V(8); PG8_WAIT_L(0); PG8_BAR; PG8_MMA(0, 0, At, B0); PG8_MMA(0, 1, At, B1); PG8_BAR; PG8_SCHED;
            PG8_LDA(At, 0, 1); PG8_STAGE_B(PG8_SB(0, 0), b2); PG8_STAGE_B(PG8_SB(0, 1), b2 + hstepB); PG8_STAGE_A(PG8_SA(0, 0), a2, o00, o01);
            PG8_WAIT_V(8); PG8_WAIT_L(0); PG8_BAR; PG8_MMA(1, 0, At, B0); PG8_MMA(1, 1, At, B1); PG8_BAR; PG8_SCHED;
            PG8_LDB(B0, 1, 0); PG8_LDB(B1, 1, 1); PG8_SCHED; PG8_LDA(At, 1, 0); PG8_STAGE_A(PG8_SA(0, 1), a2, o10, o11);
            PG8_WAIT_V(8); PG8_WAIT_L(0); PG8_BAR; PG8_MMA(0, 0, At, B0); PG8_MMA(0, 1, At, B1); PG8_BAR; PG8_SCHED;
            PG8_LDA(At, 1, 1); PG8_STAGE_B(PG8_SB(1, 0), b3); PG8_STAGE_B(PG8_SB(1, 1), b3 + hstepB); PG8_STAGE_A(PG8_SA(1, 0), a3, o00, o01);
            PG8_WAIT_V(8); PG8_WAIT_L(0); PG8_BAR; PG8_MMA(1, 0, At, B0); PG8_MMA(1, 1, At, B1); PG8_BAR; PG8_SCHED;
        }
        if constexpr (ALIGN_EPI) { if (wr == 0) PG8_BAR; }
        bool keep = false;
        if constexpr (Epi::SEG2) keep = (cur.seg == 0);
        if (keep) E.mid(acc, cur, wr, wc, fr, fq); else E(acc, cur, wr, wc, fr, fq);
        if (!has_next) break;
        if (!keep) {
#pragma unroll
            for (int a = 0; a < 2; ++a)
#pragma unroll
                for (int b = 0; b < 2; ++b)
#pragma unroll
                    for (int m = 0; m < 4; ++m)
#pragma unroll
                        for (int n = 0; n < 2; ++n) acc[a][b][m][n] = (f32x4){0.f, 0.f, 0.f, 0.f};
        }
        cur = nxt; cA = nA; cB = nB; ++ui;
#pragma unroll
        for (int h = 0; h < 2; ++h)
#pragma unroll
            for (int i = 0; i < 2; ++i) ca[h][i] = na[h][i];
        if constexpr (ALIGN_EPI) { if (wr == 1) PG8_BAR; }
    }
    PG8_WAIT_V(0);
    if constexpr (!ALIGN_EPI) { if (wr == 0) PG8_BAR; }
    PG8_BAR;
#undef PG8_SA
#undef PG8_SB
#undef PG8_STAGE_A
#undef PG8_STAGE_B
#undef PG8_LDA
#undef PG8_LDB
#undef PG8_MMA
#undef PG8_WAIT_V
#undef PG8_WAIT_L
#undef PG8_BAR
#undef PG8_SCHED
}
}
namespace attn_body {
using bf16=__hip_bfloat16;
constexpr int BATCH=8,NHEAD=8,NKVH=2,SEQ=8192,D=64,QP=NHEAD*D,KP=NKVH*D;
constexpr int NW=8,QBLK=32,QB=QBLK*NW,KVBLK=64,NQB=SEQ/QB;
constexpr int ATTN_UNIT_ROWS=QB;
__device__ __forceinline__ int crow(int r,int hi){return (r&3)+8*(r>>2)+4*hi;}
#define SBAR() __builtin_amdgcn_sched_barrier(0)
constexpr int NSLOT=3, SLOTB=8192;
constexpr int LDS_K=0, LDS_V=NSLOT*SLOTB, LDS_WS=2*NSLOT*SLOTB, LDS_OST=LDS_WS+NW*64*4, LDS_BYTES=LDS_OST+NW*4096;
constexpr float C2=0.125f*1.4426950408889634f;
__device__ __forceinline__ void glds16(const void*gsrc,unsigned lds_dst){unsigned keep;
  asm volatile("s_mov_b32 %0, m0\n\ts_mov_b32 m0, %2\n\ts_nop 0\n\tglobal_load_lds_dwordx4 %1, off\n\ts_mov_b32 m0, %0":"=&s"(keep):"v"(gsrc),"s"(lds_dst):"memory");}
typedef float f32x2_t __attribute__((ext_vector_type(2))); typedef __bf16 bf16x2_t __attribute__((ext_vector_type(2)));
__device__ __forceinline__ unsigned cvtpk_s(float lo,float hi){f32x2_t v={lo,hi};bf16x2_t b=__builtin_convertvector(v,bf16x2_t);return __builtin_bit_cast(unsigned,b);}
#define WAIT_BAR(N) asm volatile("s_waitcnt vmcnt(" #N ") lgkmcnt(0)\n\ts_barrier":::"memory")

__device__ __forceinline__ void qkt(f32x16&p0,f32x16&p1,const char*Kslot,const bf16x8*qr,const f32x16&negm,int r32,int hi){
  const char*kb=Kslot+hi*1024+r32*16;
  #pragma unroll
  for(int d0=0;d0<4;++d0){
    const bf16x8 b0=*reinterpret_cast<const bf16x8*>(kb+d0*2048);
    const bf16x8 b1=*reinterpret_cast<const bf16x8*>(kb+d0*2048+512);
    if(d0==0){p0=__builtin_amdgcn_mfma_f32_32x32x16_bf16(b0,qr[0],negm,0,0,0);p1=__builtin_amdgcn_mfma_f32_32x32x16_bf16(b1,qr[0],negm,0,0,0);}
    else{p0=__builtin_amdgcn_mfma_f32_32x32x16_bf16(b0,qr[d0],p0,0,0,0);p1=__builtin_amdgcn_mfma_f32_32x32x16_bf16(b1,qr[d0],p1,0,0,0);}}
}
typedef __attribute__((address_space(3))) const char* lds_cptr;
typedef short v4i16_t __attribute__((ext_vector_type(4)));
__device__ __forceinline__ void kload8(bf16x8*kf,lds_cptr kp){
  kf[0]=*(const __attribute__((address_space(3))) bf16x8*)(kp);      kf[1]=*(const __attribute__((address_space(3))) bf16x8*)(kp+512);
  kf[2]=*(const __attribute__((address_space(3))) bf16x8*)(kp+2048); kf[3]=*(const __attribute__((address_space(3))) bf16x8*)(kp+2560);
  kf[4]=*(const __attribute__((address_space(3))) bf16x8*)(kp+4096); kf[5]=*(const __attribute__((address_space(3))) bf16x8*)(kp+4608);
  kf[6]=*(const __attribute__((address_space(3))) bf16x8*)(kp+6144); kf[7]=*(const __attribute__((address_space(3))) bf16x8*)(kp+6656);
}
__device__ __forceinline__ void kload2(bf16x8*kf,lds_cptr kp,int j){ kf[2*j]=*(const __attribute__((address_space(3))) bf16x8*)(kp+j*2048); kf[2*j+1]=*(const __attribute__((address_space(3))) bf16x8*)(kp+j*2048+512); }
__device__ __forceinline__ s16x4 vtr(lds_cptr p){ return __builtin_bit_cast(s16x4,__builtin_amdgcn_ds_read_tr16_b64_v4i16((__attribute__((address_space(3))) v4i16_t*)p)); }
__device__ __forceinline__ void pv(f32x16*o,int vb,bf16x8 pa0,bf16x8 pa1,bf16x8 pa2,bf16x8 pa3){
  #pragma unroll
  for(int d0=0;d0<2;++d0){s16x4 lo[4],hi[4];
    #pragma unroll
    for(int ks=0;ks<4;++ks){
      asm volatile("ds_read_b64_tr_b16 %0,%1 offset:%c2":"=&v"(lo[ks]):"v"(vb),"i"(d0*4096+ks*1024):"memory");
      asm volatile("ds_read_b64_tr_b16 %0,%1 offset:%c2":"=&v"(hi[ks]):"v"(vb),"i"(d0*4096+ks*1024+512):"memory");}
    asm volatile("s_waitcnt lgkmcnt(0)":::"memory");SBAR();
    #define PK(k) (bf16x8){lo[k][0],lo[k][1],lo[k][2],lo[k][3],hi[k][0],hi[k][1],hi[k][2],hi[k][3]}
    o[d0]=__builtin_amdgcn_mfma_f32_32x32x16_bf16(pa0,PK(0),o[d0],0,0,0);
    o[d0]=__builtin_amdgcn_mfma_f32_32x32x16_bf16(pa1,PK(1),o[d0],0,0,0);
    o[d0]=__builtin_amdgcn_mfma_f32_32x32x16_bf16(pa2,PK(2),o[d0],0,0,0);
    o[d0]=__builtin_amdgcn_mfma_f32_32x32x16_bf16(pa3,PK(3),o[d0],0,0,0);
    #undef PK
  }
}

#ifndef ATTN_STORE16
#define ATTN_STORE16(p,v) (*(u32x4*)(p)=(v))
#endif
__device__ __forceinline__ void attn_unit(int b,int h,int qb,const bf16*Q,const bf16*__restrict__ K,const bf16*__restrict__ V,bf16*O,char*shm,float mbound,int wave){
  int tid_=wave*64+mk_lane(); asm volatile("":"+v"(tid_)); const int tid=tid_,lane=tid&63,r32=lane&31,hi=lane>>5; const int wid=__builtin_amdgcn_readfirstlane(tid>>6);
  const long rowbase=(long)b*SEQ; const int q0=qb*QB;
  const bf16*Qw=Q+(rowbase+q0+wid*QBLK)*QP+h*D;
  const bf16*Kh=K+rowbase*KP+(h>>2)*D,*Vh=V+rowbase*KP+(h>>2)*D;
  const unsigned lds0=(unsigned)(uintptr_t)shm;
  float*wsf=(float*)(shm+LDS_WS)+wid*64;
  const bf16*ksrc=Kh+(long)lane*KP+wid*8;
  const bf16*vsrc=Vh+(long)(16*(wid&3)+(lane>>2))*KP+(wid>>2)*32+(lane&3)*8;
  const unsigned kdst=lds0+LDS_K+wid*1024, vdst=lds0+LDS_V+wid*1024;
  #define DMA_K(t,slot) glds16(ksrc+(long)(t)*KVBLK*KP,(unsigned)__builtin_amdgcn_readfirstlane(kdst+(slot)))
  #define DMA_V(t,slot) glds16(vsrc+(long)(t)*KVBLK*KP,(unsigned)__builtin_amdgcn_readfirstlane(vdst+(slot)))
  const int vb0=(int)(lds0+LDS_V)+((lane>>4)&1)*32+(lane&3)*8+(4*hi+((lane&15)>>2))*64;
  const char*Kbase=shm+LDS_K; bf16x8 kf[8];
  const lds_cptr shm3=(lds_cptr)shm; const lds_cptr kp0=shm3+LDS_K+hi*1024+r32*16; const lds_cptr vp0=shm3+LDS_V+((lane>>4)&1)*32+(lane&3)*8+(4*hi+((lane&15)>>2))*64;
  constexpr int NT=SEQ/KVBLK;
  DMA_K(0,0);DMA_V(0,0);DMA_K(1,SLOTB);
  bf16x8 qr[4];
  #pragma unroll
  for(int d0=0;d0<4;++d0)qr[d0]=*reinterpret_cast<const bf16x8*>(&Qw[(long)r32*QP+d0*16+hi*8]);
  float l_reg=0.f;f32x16 o[2];o[0]=f32x16{};o[1]=f32x16{};f32x16 negm;
  _Pragma("unroll") for(int r=0;r<16;++r)negm[r]=-mbound; asm volatile("":"+v"(negm));
  #define START(P0,P1) do{ _Pragma("unroll") for(int r=0;r<16;++r)P0[r]=__builtin_amdgcn_exp2f(P0[r]); }while(0)
  #define RESC() do{}while(0)
  f32x16 pA0,pA1,pB0,pB1;
  int sl_prev=0,sl_cur=0,sl_next=SLOTB;
  #define ROT() do{sl_prev=sl_cur;sl_cur=sl_next;sl_next=(sl_next==(NSLOT-1)*SLOTB)?0:sl_next+SLOTB;}while(0)
  DMA_K(2,2*SLOTB);
  WAIT_BAR(3);
  qkt(pA0,pA1,Kbase,qr,negm,r32,hi);asm volatile("s_nop 15\n\ts_nop 7":"+v"(pA0),"+v"(pA1));
  START(pA0,pA1);
  _Pragma("unroll") for(int r=0;r<16;++r)pA1[r]=__builtin_amdgcn_exp2f(pA1[r]);
  WAIT_BAR(0);
  DMA_K(3,0);DMA_V(1,SLOTB);
  ROT();
  kload8(kf,kp0+sl_cur);
  WAIT_BAR(2);
  s16x4 vlo[8],vhi[8]; u32x4 pw0,pw1,pw2,pw3;
  #define PKW(P,B) cvtpk_s(P[B],P[B+1])
  #define PAF(k) __builtin_bit_cast(bf16x8,pw##k)
  #define VFR(i) (bf16x8){vlo[i][0],vlo[i][1],vlo[i][2],vlo[i][3],vhi[i][0],vhi[i][1],vhi[i][2],vhi[i][3]}
  #define PIN(x) asm volatile("":"+v"(x))
  #define MX3(a,b,c) __builtin_fmaxf(__builtin_fmaxf((a),(b)),(c))
  #define GAPA(MF,A0,A1,A2,A3,W0,W1,PW) do{ MF; sacc+=A0; sacc+=A1; sacc+=A2; sacc+=A3; PIN(sacc); W0; W1; PIN(PW); SBAR(); }while(0)
  #define EX(v) __builtin_amdgcn_exp2f(v)
  #define GAPB(MF,X,B) do{ MF; X[B]=EX(X[B]); X[B+1]=EX(X[B+1]); X[B+2]=EX(X[B+2]); X[B+3]=EX(X[B+3]); PIN(X); SBAR(); }while(0)
  #define VRD(i) do{ vlo[i]=vtr(vp_+(((i)>>2)*4096+((i)&3)*1024)); vhi[i]=vtr(vp_+(((i)>>2)*4096+((i)&3)*1024+512)); }while(0)
  #define KRD(G,j) do{ if(G){ kload2(kf,kp0+sl_next,j); SBAR(); } }while(0)
  #define STEP(C0,C1,P0,P1,t,GK,GV,GL) do{ SBAR(); \
    const lds_cptr vp_=vp0+sl_prev; \
    VRD(0); SBAR(); float sacc=(P0[0]+P0[1]); \
    GAPA(C0=__builtin_amdgcn_mfma_f32_32x32x16_bf16(kf[0],qr[0],negm,0,0,0), P0[2],P0[3],P0[4],P0[5],     pw0[0]=PKW(P0,0), pw0[1]=PKW(P0,2), pw0); \
    VRD(4); SBAR(); GAPA(C1=__builtin_amdgcn_mfma_f32_32x32x16_bf16(kf[1],qr[0],negm,0,0,0), P0[6],P0[7],P0[8],P0[9],     pw0[2]=PKW(P0,4), pw0[3]=PKW(P0,6), pw0); \
    VRD(1); SBAR(); GAPA(C0=__builtin_amdgcn_mfma_f32_32x32x16_bf16(kf[2],qr[1],C0,0,0,0),   P0[10],P0[11],P0[12],P0[13], pw1[0]=PKW(P0,8), pw1[1]=PKW(P0,10), pw1); \
    VRD(5); SBAR(); GAPA(C1=__builtin_amdgcn_mfma_f32_32x32x16_bf16(kf[3],qr[1],C1,0,0,0),   P0[14],P0[15],P1[0],P1[1],   pw1[2]=PKW(P0,12),pw1[3]=PKW(P0,14), pw1); \
    VRD(2); SBAR(); GAPA(C0=__builtin_amdgcn_mfma_f32_32x32x16_bf16(kf[4],qr[2],C0,0,0,0),   P1[2],P1[3],P1[4],P1[5],     pw2[0]=PKW(P1,0), pw2[1]=PKW(P1,2), pw2); \
    VRD(6); SBAR(); GAPA(C1=__builtin_amdgcn_mfma_f32_32x32x16_bf16(kf[5],qr[2],C1,0,0,0),   P1[6],P1[7],P1[8],P1[9],     pw2[2]=PKW(P1,4), pw2[3]=PKW(P1,6), pw2); \
    VRD(3); SBAR(); GAPA(C0=__builtin_amdgcn_mfma_f32_32x32x16_bf16(kf[6],qr[3],C0,0,0,0),   P1[10],P1[11],P1[12],P1[13], pw3[0]=PKW(P1,8), pw3[1]=PKW(P1,10), pw3); \
    VRD(7); SBAR(); GAPA(C1=__builtin_amdgcn_mfma_f32_32x32x16_bf16(kf[7],qr[3],C1,0,0,0),   P1[14],P1[15],0.f,0.f,       pw3[2]=PKW(P1,12),pw3[3]=PKW(P1,14), pw3); \
    l_reg+=sacc; \
    if(GK){DMA_K((t)+3,sl_cur);} if(GV){DMA_V((t)+1,sl_next);} \
    SBAR(); \
    GAPB(o[0]=__builtin_amdgcn_mfma_f32_32x32x16_bf16(PAF(0),VFR(0),o[0],0,0,0), C0,0); \
    GAPB(o[1]=__builtin_amdgcn_mfma_f32_32x32x16_bf16(PAF(0),VFR(4),o[1],0,0,0), C0,4); \
    KRD(GL,0); GAPB(o[0]=__builtin_amdgcn_mfma_f32_32x32x16_bf16(PAF(1),VFR(1),o[0],0,0,0), C0,8); \
    KRD(GL,1); GAPB(o[1]=__builtin_amdgcn_mfma_f32_32x32x16_bf16(PAF(1),VFR(5),o[1],0,0,0), C0,12); \
    KRD(GL,2); GAPB(o[0]=__builtin_amdgcn_mfma_f32_32x32x16_bf16(PAF(2),VFR(2),o[0],0,0,0), C1,0); \
    KRD(GL,3); GAPB(o[1]=__builtin_amdgcn_mfma_f32_32x32x16_bf16(PAF(2),VFR(6),o[1],0,0,0), C1,4); \
    GAPB(o[0]=__builtin_amdgcn_mfma_f32_32x32x16_bf16(PAF(3),VFR(3),o[0],0,0,0), C1,8); \
    GAPB(o[1]=__builtin_amdgcn_mfma_f32_32x32x16_bf16(PAF(3),VFR(7),o[1],0,0,0), C1,12); \
    }while(0)
  int t=1;
  for(;t+5<NT;t+=2){
    STEP(pB0,pB1,pA0,pA1,t,true,true,true);     WAIT_BAR(2); RESC(); ROT();
    STEP(pA0,pA1,pB0,pB1,t+1,true,true,true);   WAIT_BAR(2); RESC(); ROT();
  }
  #define ENDW(tt) do{ if((tt)+3<NT){WAIT_BAR(2);} else if((tt)+2<NT){WAIT_BAR(1);} else {WAIT_BAR(0);} }while(0)
  for(;t+1<NT;t+=2){
    STEP(pB0,pB1,pA0,pA1,t,(t+3<NT),(t+1<NT),(t+1<NT));       ENDW(t);   RESC(); ROT();
    STEP(pA0,pA1,pB0,pB1,t+1,(t+4<NT),(t+2<NT),(t+2<NT));     ENDW(t+1); RESC(); ROT();
  }
  STEP(pB0,pB1,pA0,pA1,NT-1,false,false,false); RESC();
  { float sacc=pB0[0]+pB0[1]; _Pragma("unroll") for(int r=2;r<16;++r)sacc+=pB0[r]; _Pragma("unroll") for(int r=0;r<16;++r)sacc+=pB1[r]; l_reg+=sacc;
    pw0=(u32x4){PKW(pB0,0),PKW(pB0,2),PKW(pB0,4),PKW(pB0,6)};pw1=(u32x4){PKW(pB0,8),PKW(pB0,10),PKW(pB0,12),PKW(pB0,14)};pw2=(u32x4){PKW(pB1,0),PKW(pB1,2),PKW(pB1,4),PKW(pB1,6)};pw3=(u32x4){PKW(pB1,8),PKW(pB1,10),PKW(pB1,12),PKW(pB1,14)};
    SBAR(); pv(o,vb0+sl_cur,PAF(0),PAF(1),PAF(2),PAF(3)); }
  #undef PKW
  #undef PAF
  #undef VFR
  #undef PIN
  #undef MX3
  #undef GAPA
  #undef GAPB
  #undef EX
  #undef VRD
  #undef KRD
  #undef STEP
  #undef ENDW
  {auto rr=__builtin_amdgcn_permlane32_swap(__float_as_uint(l_reg),__float_as_uint(l_reg),false,false);l_reg=__uint_as_float(rr[0])+__uint_as_float(rr[1]);}
  if(hi==0)wsf[32+r32]=l_reg;asm volatile("s_waitcnt lgkmcnt(0)":::"memory");
  float rli[16];
  #pragma unroll
  for(int r=0;r<16;++r)rli[r]=__builtin_amdgcn_rcpf(wsf[32+crow(r,hi)]);
  bf16*Ow=O+(rowbase+q0+wid*QBLK)*QP+h*D;
  { bf16*stg=(bf16*)(shm+LDS_OST)+wid*2048;
    #pragma unroll
    for(int r=0;r<16;++r){const int orow=crow(r,hi);
      #pragma unroll
      for(int d0=0;d0<2;++d0)stg[orow*64+d0*32+r32]=__float2bfloat16(o[d0][r]*rli[r]);}
    asm volatile("s_waitcnt lgkmcnt(0)":::"memory");
    #pragma unroll
    for(int i=0;i<4;++i){const int row=i*8+(lane>>3),ch=lane&7; const u32x4 v=*(const u32x4*)(stg+row*64+ch*8); ATTN_STORE16(Ow+(long)row*QP+ch*8,v);} }
  asm volatile("s_waitcnt lgkmcnt(0)\n\ts_barrier":::"memory");
  #undef DMA_K
  #undef DMA_V
  #undef START
  #undef RESC
  #undef ROT
}
constexpr int ATTN_LDS_BYTES=LDS_BYTES;
#undef SBAR
#undef WAIT_BAR
}
constexpr int NWAVES = 8;
constexpr int BATCH = 8, SEQ = 8192, DMODEL = 1024, MTOK = BATCH * SEQ;
constexpr int D_IN = 5376;
constexpr int NEXP = 32, DEXP = 512, NLIST = 64, LIST_CAP = MTOK;
constexpr float EPS = 1e-6f, HGRN_SCALE = 0.08838834764831845f;
constexpr float C2 = 0.125f * 1.4426950408889634f;

constexpr size_t MiB = 1u << 20;
constexpr size_t WS_CTL = 0, CTL_ZERO_BYTES = 262144;
constexpr size_t WS_ROPE = 1 * MiB;
constexpr size_t WS_LBV = WS_ROPE + 64 * 1024;
constexpr size_t WS_QKN = WS_LBV + 8192;
constexpr size_t WS_RSTD1 = WS_LBV + 64 * 1024;
constexpr size_t WS_RSTD2 = WS_RSTD1 + 256 * 1024;
constexpr size_t WS_WR = WS_RSTD2 + 256 * 1024;
constexpr size_t WS_TOK = WS_WR + 256 * 1024;
constexpr size_t WS_SX1 = 3 * MiB + 256 * 1024;
constexpr size_t WS_SWGU = WS_SX1 + 256 * 1024;
constexpr size_t WS_RSTD1Q = WS_SWGU + 128 * 1024;
constexpr size_t WS_SWIN = WS_RSTD1Q + 256 * 1024;
constexpr size_t WS_WIN = 4 * MiB;
constexpr size_t WS_WA = 15 * MiB, WS_WB = 16 * MiB, WS_WOUT = 17 * MiB;
constexpr size_t WS_WD = 20 * MiB;
constexpr size_t WS_WGU = 52 * MiB;
constexpr size_t WS_Q = 244 * MiB;
constexpr size_t WS_K = 308 * MiB, WS_V = 324 * MiB;
constexpr size_t WS_X1Q = WS_Q;
constexpr size_t WS_WGUQ = WS_K;
constexpr size_t WS_QEF = 340 * MiB, WS_KEF = 404 * MiB;
constexpr size_t WS_MERGED = WS_QEF, WS_HID = WS_QEF;
constexpr size_t WS_QEB = 468 * MiB, WS_KEB = 532 * MiB;
constexpr size_t WS_X1B = WS_QEB;
constexpr int Y0_PITCH = 1024 + 64;
constexpr size_t WS_Y0 = 596 * MiB;
constexpr size_t WS_VH = 596 * MiB;
constexpr size_t WS_SSQ = WS_VH;
constexpr size_t WS_AMX = WS_VH + 4 * MiB;
constexpr size_t WS_OG = 660 * MiB;
constexpr size_t WS_VEC = 724 * MiB;
constexpr size_t WS_CVEC = 740 * MiB;
constexpr size_t WS_OF = 748 * MiB, WS_OB = 812 * MiB;
constexpr size_t WS_LIST = 876 * MiB;
constexpr size_t WS_X0Q = 892 * MiB;
constexpr size_t WS_WINQ = 956 * MiB;
constexpr size_t WS_PLIST = 962 * MiB;
constexpr size_t WS_END = 990 * MiB;

constexpr int CW_TMO = 0, CW_CODE = 1;
constexpr int CW_BAR = 4096;
constexpr int CW_QHEAD = 8192;
constexpr int CW_HFLAG = 12288;
constexpr int CW_CNT = 16384;
constexpr int NPAIR = 112;
constexpr int CW_PCNT = 32768;
constexpr int CW_WINCNT = 24576;
static_assert((CW_CNT + 64 * 64) <= CW_WINCNT && CW_WINCNT + 64 <= CW_PCNT && (CW_PCNT + 16 * NPAIR) * 4 <= (int)CTL_ZERO_BYTES, "control words inside the per-call memset");

constexpr int RING_OFF = 0, RING_BYTES = 131072;
constexpr int SCAN_LDS_BYTES = 153600;
constexpr int LDSCTL_OFF = SCAN_LDS_BYTES, MISC_OFF = LDSCTL_OFF + 320;
constexpr int MOETAB_OFF = LDSCTL_OFF + 1024;
constexpr int ROPE_LDS_OFF = RING_BYTES;
constexpr int LDS_BYTES = LDSCTL_OFF + 2048;
static_assert(ROPE_LDS_OFF + 16384 + 4096 <= LDSCTL_OFF && LDS_BYTES <= 163840, "LDS map");

typedef GAS unsigned gu32;
#define RLX_AGENT __ATOMIC_RELAXED, __HIP_MEMORY_SCOPE_AGENT
#define LDS_WAIT() asm volatile("s_waitcnt lgkmcnt(0)" ::: "memory")
#define VM_WAIT() asm volatile("s_waitcnt vmcnt(0)" ::: "memory")

#define XB_TMO      128
#define XB_XCNT(j)  (256  + 64 * (j))
#define XB_XSUB(j)  (1280 + 64 * (j))
#define XB_XGEN(j)  (2304 + 64 * (j))
#define XB_TOP      3328
#define XB_TOPGEN   3392
#define XCD_BAR_WORDS 3456
#define XB_SPIN_CAP (1u << 18)

__device__ __forceinline__ unsigned xb_ld(unsigned* p)              { return __hip_atomic_load(p, __ATOMIC_RELAXED, __HIP_MEMORY_SCOPE_AGENT); }
__device__ __forceinline__ unsigned xb_add(unsigned* p, unsigned v) { return __hip_atomic_fetch_add(p, v, __ATOMIC_RELAXED, __HIP_MEMORY_SCOPE_AGENT); }
__device__ __forceinline__ unsigned xb_xcc_id() { return (unsigned)__builtin_amdgcn_s_getreg((3 << 11) | 20) & 0xFu; }
#define XB_SPIN(cond, bar) do { unsigned _sp = 0; while (cond) { __builtin_amdgcn_s_sleep(1); \
    if ((++_sp & 255u) == 0u) { if (xb_ld(&(bar)[XB_TMO])) break; if (_sp > XB_SPIN_CAP) { atomicAdd(&(bar)[XB_TMO], 1u); break; } } } } while (0)

struct XcdBarrier { unsigned* bar; unsigned x; volatile LAS unsigned* st; };

__device__ __forceinline__ XcdBarrier xcd_barrier_post(unsigned* bar, volatile LAS unsigned* st, bool leader) {
    XcdBarrier b; b.bar = bar; b.x = xb_xcc_id(); b.st = st;
    if (leader) (void)xb_add(&bar[XB_XCNT(b.x)], 1u);
    return b;
}
__device__ __forceinline__ void xcd_barrier_complete(unsigned* bar, unsigned x, unsigned& nloc, unsigned& nx) {
    const unsigned G = gridDim.x * gridDim.y * gridDim.z;
    unsigned sum, cnt, mine, sp = 0u;
    for (;;) {
        sum = 0u; cnt = 0u; mine = 0u;
#pragma unroll
        for (unsigned j = 0; j < 16; ++j) { const unsigned c = xb_ld(&bar[XB_XCNT(j)]); sum += c; cnt += (c > 0u) ? 1u : 0u; mine = (j == x) ? c : mine; }
        if (sum == G) break;
        __builtin_amdgcn_s_sleep(1);
        if ((++sp & 255u) == 0u) { if (xb_ld(&bar[XB_TMO])) break; if (sp > XB_SPIN_CAP) { atomicAdd(&bar[XB_TMO], 1u); break; } }
    }
    nloc = mine > 0u ? mine : 1u; nx = cnt > 0u ? cnt : 1u;
}
__device__ __forceinline__ void xcd_barrier(const XcdBarrier& b, bool leader) {
    asm volatile("s_waitcnt vmcnt(0)" ::: "memory");
    __syncthreads();
    if (leader) {
        unsigned* bar = b.bar;
        __builtin_amdgcn_s_waitcnt(0);
        unsigned nloc = b.st[0], nx = b.st[1];
        if (nloc == 0u) { xcd_barrier_complete(bar, b.x, nloc, nx); b.st[0] = nloc; b.st[1] = nx; }
        const unsigned old = xb_add(&bar[XB_XSUB(b.x)], 1u);
        const unsigned gen = old / nloc;
        if (old + 1u == (gen + 1u) * nloc) {
            __builtin_amdgcn_fence(__ATOMIC_RELEASE, "agent");
            asm volatile("s_waitcnt vmcnt(0)" ::: "memory");
            const unsigned og = xb_add(&bar[XB_TOP], 1u);
            const unsigned tg = og / nx;
            if (og + 1u == (tg + 1u) * nx) xb_add(&bar[XB_TOPGEN], 1u);
            else XB_SPIN(xb_ld(&bar[XB_TOPGEN]) == tg, bar);
            __builtin_amdgcn_fence(__ATOMIC_ACQUIRE, "agent");
            xb_add(&bar[XB_XGEN(b.x)], 1u);
            asm volatile("s_waitcnt vmcnt(0)" ::: "memory");
        } else {
            XB_SPIN(xb_ld(&bar[XB_XGEN(b.x)]) == gen, bar);
            __builtin_amdgcn_fence(__ATOMIC_ACQUIRE, "agent");
            asm volatile("s_waitcnt vmcnt(0)" ::: "memory");
        }
    }
    __syncthreads();
}

struct Frame {
    LAS unsigned char* lds;
    volatile LAS unsigned* MISC;
    gu32* ctl;
    int wave;
    int vcu, G;
    unsigned char* ws; float* out;
    const float* in[19];
};
__device__ __forceinline__ float wave_sum(float v) {
#pragma unroll
    for (int o = 1; o < 64; o <<= 1) v += __shfl_xor(v, o);
    return v;
}
__device__ __forceinline__ int win_colmap(int p) {
    const int pn = p >> 8, pp = p & 255;
    if (pn <= 2) return 256 * pn + 64 * ((pp >> 5) & 3) + 32 * (pp >> 7) + (pp & 31);
    if (pn <= 10) { const int T = pn - 3, bj = pp >> 7, wc = (pp >> 5) & 3, fq = (pp >> 3) & 3, n = (pp >> 2) & 1, i = pp & 3;
        const int qty = 2 * bj + n, ch = 64 * T + 16 * wc + 4 * fq + i;
        return 768 + 512 * qty + ch; }
    if (pn <= 12) return p;
    { const int T = pn - 13; return (pp < 128) ? (3328 + 128 * T + pp) : (4352 + 128 * T + (pp - 128)); }
}
template <class SrcF>
__device__ __forceinline__ void p0_item(const SrcF& src, int K, int nrows, bf16_t* WT, LAS float* scr, int item, int lane, unsigned* colmax = nullptr) {
    const int nblk = nrows / 32, kb = item / nblk, nb = item % nblk, k0 = 64 * kb, n0 = 32 * nb;
    float tv[32];
#pragma unroll
    for (int i = 0; i < 32; ++i) tv[i] = src(k0 + 2 * i + (lane >> 5), n0 + (lane & 31));
    if (colmax) { float mx = 0.f;
#pragma unroll
        for (int i = 0; i < 32; ++i) mx = fmaxf(mx, fabsf(tv[i]));
        mx = fmaxf(mx, __shfl_xor(mx, 32));
        if (lane < 32) atomicMax(colmax + n0 + lane, __float_as_uint(mx)); }
#pragma unroll
    for (int i = 0; i < 32; ++i) { const int kk = 2 * i + (lane >> 5); scr[kk * 33 + (lane & 31)] = tv[i]; }
    LDS_WAIT(); asm volatile("" ::: "memory");
    const int c = lane & 7;
#pragma unroll
    for (int j = 0; j < 4; ++j) { const int n = (lane >> 3) + 8 * j; const LAS float* s = scr + (8 * c) * 33 + n;
        u32x4 o; o.x = cvtpk(s[0 * 33], s[1 * 33]); o.y = cvtpk(s[2 * 33], s[3 * 33]); o.z = cvtpk(s[4 * 33], s[5 * 33]); o.w = cvtpk(s[6 * 33], s[7 * 33]);
        *(GAS u32x4*)(WT + (size_t)(n0 + n) * K + k0 + 8 * c) = o; }
    LDS_WAIT(); asm volatile("" ::: "memory");
}
struct SrcWin { const float* W; const float* g; __device__ __forceinline__ float operator()(int k, int p) const { return g[k] * W[(size_t)k * D_IN + win_colmap(p)]; } };
struct SrcPlain { const float* W; int N; __device__ __forceinline__ float operator()(int k, int p) const { return W[(size_t)k * N + p]; } };
struct SrcWb { const float* W; const float* g; __device__ __forceinline__ float operator()(int k, int p) const { return g[k & 127] * W[(size_t)k * 1024 + p]; } };
struct SrcGu { const float* Wg; const float* Wu; const float* g;
    __device__ __forceinline__ float operator()(int k, int p) const { const int s = (p >> 7) & 1, j = 128 * (p >> 8) + (p & 127); const float* W = (const float*)((uintptr_t)Wg + (s ? ((uintptr_t)Wu - (uintptr_t)Wg) : (uintptr_t)0)); return g[k] * W[(size_t)k * 512 + j]; } };

__device__ __forceinline__ void quant_rows1024(const bf16_t* src, unsigned char* dst, float* scale, int nrows, int gw, int NGW) {
    const int lane = mk_lane();
    for (int p0 = gw; p0 < nrows; p0 += 4 * NGW) {
        u32x4 a[4], b[4];
#pragma unroll
        for (int r = 0; r < 4; ++r) { const int p = p0 + r * NGW; const int pc = p < nrows ? p : p0;
            a[r] = *(const GAS u32x4*)(src + (size_t)pc * 1024 + lane * 16); b[r] = *(const GAS u32x4*)(src + (size_t)pc * 1024 + lane * 16 + 8); }
        __builtin_amdgcn_sched_barrier(0);
#pragma unroll
        for (int r = 0; r < 4; ++r) { const int p = p0 + r * NGW;
            float mx = 0.f;
#pragma unroll
            for (int i = 0; i < 4; ++i) { mx = fmaxf(fmaxf(mx, fmaxf(fabsf(bf_lo(a[r][i])), fabsf(bf_hi(a[r][i])))), fmaxf(fabsf(bf_lo(b[r][i])), fabsf(bf_hi(b[r][i])))); }
#pragma unroll
            for (int o = 1; o < 64; o <<= 1) mx = fmaxf(mx, __shfl_xor(mx, o));
            const float amax = fmaxf(mx, 1e-30f), qs = 127.0f / amax;
            u32x4 q = {0u, 0u, 0u, 0u};
#pragma unroll
            for (int i = 0; i < 2; ++i) { q[i] = __builtin_amdgcn_cvt_pk_u8_f32(rintf(bf_lo(a[r][2 * i]) * qs) + 128.0f, 0, q[i]); q[i] = __builtin_amdgcn_cvt_pk_u8_f32(rintf(bf_hi(a[r][2 * i]) * qs) + 128.0f, 1, q[i]);
                q[i] = __builtin_amdgcn_cvt_pk_u8_f32(rintf(bf_lo(a[r][2 * i + 1]) * qs) + 128.0f, 2, q[i]); q[i] = __builtin_amdgcn_cvt_pk_u8_f32(rintf(bf_hi(a[r][2 * i + 1]) * qs) + 128.0f, 3, q[i]);
                q[2 + i] = __builtin_amdgcn_cvt_pk_u8_f32(rintf(bf_lo(b[r][2 * i]) * qs) + 128.0f, 0, q[2 + i]); q[2 + i] = __builtin_amdgcn_cvt_pk_u8_f32(rintf(bf_hi(b[r][2 * i]) * qs) + 128.0f, 1, q[2 + i]);
                q[2 + i] = __builtin_amdgcn_cvt_pk_u8_f32(rintf(bf_lo(b[r][2 * i + 1]) * qs) + 128.0f, 2, q[2 + i]); q[2 + i] = __builtin_amdgcn_cvt_pk_u8_f32(rintf(bf_hi(b[r][2 * i + 1]) * qs) + 128.0f, 3, q[2 + i]); }
            q = q ^ (u32x4){0x80808080u, 0x80808080u, 0x80808080u, 0x80808080u};
            if (p < nrows) { *(GAS u32x4*)(dst + (size_t)p * 1024 + lane * 16) = q; if (lane == 0) scale[p] = amax * (1.0f / 127.0f); } }
    }
}
__device__ __forceinline__ void winq_rows(Frame& F) {
    quant_rows1024((const bf16_t*)(F.ws + WS_WIN), F.ws + WS_WINQ, (float*)(F.ws + WS_SWIN), D_IN, F.vcu * NWAVES + F.wave, F.G * NWAVES);
}
__device__ __forceinline__ void p0_prologue(Frame& F) {
    LAS float* scr = (LAS float*)(F.lds + RING_OFF + F.wave * 16384);
    const int gw = F.vcu * NWAVES + F.wave, NGW = F.G * NWAVES;
    const float* g_mix = F.in[1]; const float* w_in = F.in[2]; const float* hgrn_norm = F.in[5];
    const float* w_attn = F.in[8]; const float* w_hgrn = F.in[9]; const float* w_out = F.in[10]; const float* g_ffn = F.in[11];
    const float* w_gate = F.in[16]; const float* w_up = F.in[17]; const float* w_down = F.in[18];
    bf16_t* Win_t = (bf16_t*)(F.ws + WS_WIN); bf16_t* Wa_t = (bf16_t*)(F.ws + WS_WA); bf16_t* Wb_t = (bf16_t*)(F.ws + WS_WB); bf16_t* Wout_t = (bf16_t*)(F.ws + WS_WOUT);
    bf16_t* Wd_t = (bf16_t*)(F.ws + WS_WD); bf16_t* Wgu_t = (bf16_t*)(F.ws + WS_WGU);
    constexpr int I_IN = (1024 / 64) * (D_IN / 32), I_A = (512 / 64) * (1024 / 32), I_OUT = (1024 / 64) * (1024 / 32);
    constexpr int I_GU1 = (1024 / 64) * (1024 / 32), I_D1 = (512 / 64) * (1024 / 32);
    constexpr int NITEMS = 2 * I_A + I_OUT + NEXP * (I_GU1 + I_D1);
    for (int it = gw; it < I_IN; it += NGW) p0_item(SrcWin{w_in, g_mix}, 1024, D_IN, Win_t, scr, it, mk_lane());
    __syncthreads();
    if (F.wave == 0 && mk_lane() == 0) { __builtin_amdgcn_fence(__ATOMIC_RELEASE, "agent"); asm volatile("s_waitcnt vmcnt(0)" ::: "memory"); __hip_atomic_fetch_add((unsigned*)(F.ctl + CW_WINCNT), 1u, RLX_AGENT); }
    for (int it = (gw + NGW / 2) % NGW; it < NITEMS; it += NGW) {
        int r = it;
        if (r < I_A) { p0_item(SrcPlain{w_attn, 1024}, 512, 1024, Wa_t, scr, r, mk_lane()); continue; } r -= I_A;
        if (r < I_A) { p0_item(SrcWb{w_hgrn, hgrn_norm}, 512, 1024, Wb_t, scr, r, mk_lane()); continue; } r -= I_A;
        if (r < I_OUT) { p0_item(SrcPlain{w_out, 1024}, 1024, 1024, Wout_t, scr, r, mk_lane()); continue; } r -= I_OUT;
        if (r < NEXP * I_GU1) { const int e = r / I_GU1, q = r % I_GU1;
            p0_item(SrcGu{w_gate + (size_t)e * 1024 * 512, w_up + (size_t)e * 1024 * 512, g_ffn}, 1024, 1024, Wgu_t + (size_t)e * 1024 * 1024, scr, q, mk_lane()); continue; } r -= NEXP * I_GU1;
        { const int e = r / I_D1, q = r % I_D1; p0_item(SrcPlain{w_down + (size_t)e * 512 * 1024, 1024}, 512, 1024, Wd_t + (size_t)e * 1024 * 512, scr, q, mk_lane()); }
    }
    { const float* x = F.in[0]; float* rstd1 = (float*)(F.ws + WS_RSTD1); float* rstd1q = (float*)(F.ws + WS_RSTD1Q); unsigned char* X0Q = F.ws + WS_X0Q;
      for (int m0 = gw * 4; m0 < MTOK; m0 += NGW * 4) {
          f32x4 v[4][4]; float s[4], a[4];
#pragma unroll
          for (int r = 0; r < 4; ++r) { const GAS f32x4* xr = (const GAS f32x4*)(x + (size_t)(m0 + r) * DMODEL) + mk_lane();
#pragma unroll
              for (int j = 0; j < 4; ++j) v[r][j] = xr[64 * j]; }
#pragma unroll
          for (int r = 0; r < 4; ++r) { float t = 0.f;
#pragma unroll
              for (int j = 0; j < 4; ++j) t += (v[r][j].x * v[r][j].x + v[r][j].y * v[r][j].y) + (v[r][j].z * v[r][j].z + v[r][j].w * v[r][j].w);
              s[r] = t; float mx = 0.f;
#pragma unroll
              for (int j = 0; j < 4; ++j) mx = fmaxf(fmaxf(mx, fmaxf(fabsf(v[r][j].x), fabsf(v[r][j].y))), fmaxf(fabsf(v[r][j].z), fabsf(v[r][j].w)));
              a[r] = mx; }
#pragma unroll
          for (int o = 1; o < 64; o <<= 1) {
#pragma unroll
              for (int r = 0; r < 4; ++r) { s[r] += __shfl_xor(s[r], o); a[r] = fmaxf(a[r], __shfl_xor(a[r], o)); } }
          const int ln = mk_lane();
          if (ln < 4) { const float sv = ln == 0 ? s[0] : ln == 1 ? s[1] : ln == 2 ? s[2] : s[3]; const float av = fmaxf(ln == 0 ? a[0] : ln == 1 ? a[1] : ln == 2 ? a[2] : a[3], 1e-30f);
              const float rs = 1.0f / sqrtf(sv * (1.0f / DMODEL) + EPS); rstd1[m0 + ln] = rs; rstd1q[m0 + ln] = rs * av * (1.0f / 127.0f); }
#pragma unroll
          for (int r = 0; r < 4; ++r) { const float qs = 127.0f / fmaxf(a[r], 1e-30f); GAS unsigned* o4 = (GAS unsigned*)(X0Q + (size_t)(m0 + r) * DMODEL) + ln;
#pragma unroll
              for (int j = 0; j < 4; ++j) { unsigned q = 0u; q = __builtin_amdgcn_cvt_pk_u8_f32(rintf(v[r][j].x * qs) + 128.0f, 0, q); q = __builtin_amdgcn_cvt_pk_u8_f32(rintf(v[r][j].y * qs) + 128.0f, 1, q);
                  q = __builtin_amdgcn_cvt_pk_u8_f32(rintf(v[r][j].z * qs) + 128.0f, 2, q); q = __builtin_amdgcn_cvt_pk_u8_f32(rintf(v[r][j].w * qs) + 128.0f, 3, q); o4[64 * j] = q ^ 0x80808080u; } }
      } }
    const int gt = F.vcu * (NWAVES * 64) + (F.wave * 64 + mk_lane()), NGT = F.G * NWAVES * 64;
    { f32x2* rope = (f32x2*)(F.ws + WS_ROPE);
      for (int i = gt; i < 128 * 16; i += NGT) { const int pos = i >> 4, j = i & 15; const float inv = powf(10000.0f, -(float)(2 * j) / 32.0f); const float ang = (float)pos * inv;
          rope[i] = (f32x2){cosf(ang), sinf(ang)}; } }
    { float* lbv = (float*)(F.ws + WS_LBV); const float* lbf = F.in[6]; const float* lbb = F.in[7];
      for (int i = gt; i < 512; i += NGT) { const float a0 = lbf[i], a1 = lbf[512 + i]; const float mx = fmaxf(a0, a1), e0 = expf(a0 - mx), e1 = expf(a1 - mx); lbv[i] = e0 / (e0 + e1); }
      for (int i = gt; i < 512; i += NGT) { const float a0 = lbb[i], a1 = lbb[512 + i]; const float mx = fmaxf(a0, a1), e0 = expf(a0 - mx), e1 = expf(a1 - mx); lbv[512 + i] = e0 / (e0 + e1); }
      float* qkn = (float*)(F.ws + WS_QKN); const float* qn = F.in[3]; const float* kn = F.in[4];
      for (int i = gt; i < 64; i += NGT) { qkn[i] = qn[i]; qkn[64 + i] = kn[i]; }
      if (gt == 0) { float gq = 0.f, gk = 0.f; for (int i = 0; i < 64; ++i) { gq = fmaxf(gq, fabsf(qn[i])); gk = fmaxf(gk, fabsf(kn[i])); }
          qkn[128] = 8.0f * 1.4426950408889634f * gq * gk * 1.01f + 0.125f; } }
    { bf16_t* Wr = (bf16_t*)(F.ws + WS_WR); const float* wrg = F.in[12]; const float* wre = F.in[14];
      for (int i = gt; i < 48 * 1024; i += NGT) { const int j = i >> 10, k = i & 1023;
          float v = 0.f; if (j < 4) v = g_ffn[k] * wrg[k * 4 + j]; else if (j < 36) v = g_ffn[k] * wre[k * 32 + (j - 4)];
          const unsigned hb = cvtpk(v, 0.f) & 0xffffu; const float hf = __uint_as_float(hb << 16); const unsigned lb = cvtpk(v - hf, 0.f) & 0xffffu;
          Wr[i] = (bf16_t)hb; Wr[48 * 1024 + i] = (bf16_t)lb; } }
    if (F.wave == 0) { unsigned sp = 0; while (__builtin_amdgcn_readfirstlane((int)__hip_atomic_load((unsigned*)(F.ctl + CW_WINCNT), RLX_AGENT)) < F.G) { __builtin_amdgcn_s_sleep(8); if (++sp > (1u << 22)) break; }
      __builtin_amdgcn_fence(__ATOMIC_ACQUIRE, "agent"); asm volatile("s_waitcnt vmcnt(0)" ::: "memory"); }
    __syncthreads();
    winq_rows(F);
}
using pg8::GUnit;
struct DenseOrder {
    pg8::TileOrder T; const char* A; const char* Bt; int K; int pn_split = 1 << 20, pn_skip = 0, pn_off = 0;
    __device__ __forceinline__ bool next(int i, GUnit& u) const { int pm, pn; if (!T.tile(i, pm, pn)) return false; pn = (pn < pn_split ? pn : pn + pn_skip) + pn_off; u.pm = pm; u.pn = pn; u.seg = 1; u.aux = 0;
        u.Ab = A + (size_t)pm * 256 * K * 2; u.Bb = Bt + (size_t)pn * 256 * K * 2; return true; }
    __device__ __forceinline__ void aoff(const GUnit&, const int (&R)[2], const int (&C)[2], unsigned (&o)[2][2]) const {
#pragma unroll
        for (int h = 0; h < 2; ++h)
#pragma unroll
            for (int i = 0; i < 2; ++i) o[h][i] = (unsigned)(((h * 128 + R[i]) * K + C[i]) * 2); }
    __device__ __forceinline__ void aoff_raw(const GUnit& u, const int (&R)[2], const int (&C)[2], unsigned (&o)[2][2]) const { aoff(u, R, C, o); }
    __device__ __forceinline__ void aoff_fin(const GUnit&, unsigned (&)[2][2], const int (&)[2]) const {}
};
struct Seg2Order {
    pg8::TileOrder T; const char* ws; int K;
    __device__ __forceinline__ bool next(int i, GUnit& u) const { int pm, pn; if (!T.tile(i >> 1, pm, pn)) return false; const int s = i & 1; u.pm = pm; u.pn = pn; u.seg = s; u.aux = 0;
        u.Ab = ws + (s ? WS_OG : WS_Q) + (size_t)pm * 256 * K * 2; u.Bb = ws + (s ? WS_WB : WS_WA) + (size_t)pn * 256 * K * 2; return true; }
    __device__ __forceinline__ void aoff(const GUnit&, const int (&R)[2], const int (&C)[2], unsigned (&o)[2][2]) const {
#pragma unroll
        for (int h = 0; h < 2; ++h)
#pragma unroll
            for (int i = 0; i < 2; ++i) o[h][i] = (unsigned)(((h * 128 + R[i]) * K + C[i]) * 2); }
    __device__ __forceinline__ void aoff_raw(const GUnit& u, const int (&R)[2], const int (&C)[2], unsigned (&o)[2][2]) const { aoff(u, R, C, o); }
    __device__ __forceinline__ void aoff_fin(const GUnit&, unsigned (&)[2][2], const int (&)[2]) const {}
};
struct MoeOrder {
    const LAS int* tab; int nl, lst0, lstep; const int* lists; const char* A; const char* W; size_t wstride; int K; int G, c;
    __device__ __forceinline__ bool next(int i, GUnit& u) const {
        const int total = tab[nl] * 4; const long L = (long)i * G + c; if (L >= total) return false;
        const int u4 = (int)L >> 2; int j = 0;
        for (int st = 32; st > 0; st >>= 1) { const int t = j + st; if (t < nl && tab[t] <= u4) j = t; }
        const int li = lst0 + lstep * j;
        u.pm = u4 - tab[j]; u.pn = (int)L & 3; u.seg = 1; u.aux = li;
        u.Ab = A; u.Bb = W + (size_t)(li >> 1) * wstride + (size_t)u.pn * 256 * K * 2; return true; }
    __device__ __forceinline__ void aoff(const GUnit& u, const int (&R)[2], const int (&C)[2], unsigned (&o)[2][2]) const {
        const int n = tab[80 + u.aux]; const GAS int* lp = (const GAS int*)lists + (size_t)u.aux * LIST_CAP;
#pragma unroll
        for (int h = 0; h < 2; ++h)
#pragma unroll
            for (int i = 0; i < 2; ++i) { int ridx = u.pm * 256 + h * 128 + R[i]; ridx = ridx < n ? ridx : n - 1; const int tok = lp[ridx]; o[h][i] = (unsigned)((tok * K + C[i]) * 2); } }
    __device__ __forceinline__ void aoff_raw(const GUnit& u, const int (&R)[2], const int (&)[2], unsigned (&o)[2][2]) const {
        const int n = tab[80 + u.aux]; const GAS int* lp = (const GAS int*)lists + (size_t)u.aux * LIST_CAP;
#pragma unroll
        for (int h = 0; h < 2; ++h)
#pragma unroll
            for (int i = 0; i < 2; ++i) { int ridx = u.pm * 256 + h * 128 + R[i]; ridx = ridx < n ? ridx : n - 1; o[h][i] = (unsigned)lp[ridx]; } }
    __device__ __forceinline__ void aoff_fin(const GUnit&, unsigned (&o)[2][2], const int (&C)[2]) const {
#pragma unroll
        for (int h = 0; h < 2; ++h)
#pragma unroll
            for (int i = 0; i < 2; ++i) o[h][i] = (o[h][i] * (unsigned)K + (unsigned)C[i]) * 2u; }
};

struct PairOrder {
    static constexpr int CNT0 = 116;
    const LAS int* tab; const unsigned* plist; const char* HID; const char* W; size_t wstride; int K; int G, c;
    __device__ __forceinline__ bool next(int i, GUnit& u) const {
        const int total = tab[NPAIR] * 4; const long L = (long)(i >> 1) * G + c; if (L >= total) return false;
        const int u4 = (int)L >> 2; int l = 0;
        for (int st = 64; st > 0; st >>= 1) { const int t = l + st; if (t < NPAIR && tab[t] <= u4) l = t; }
        const int g = l / 28; int p = l - 28 * g, a = 0;
        while (p >= 7 - a) { p -= 7 - a; ++a; }
        const int b = a + 1 + p, s = i & 1;
        u.pm = u4 - tab[l]; u.pn = (int)L & 3; u.seg = s; u.aux = l;
        u.Ab = HID; u.Bb = W + (size_t)(8 * g + (s ? b : a)) * wstride + (size_t)u.pn * 256 * K * 2; return true; }
    __device__ __forceinline__ void aoff_raw(const GUnit& u, const int (&R)[2], const int (&)[2], unsigned (&o)[2][2]) const {
        const int n = tab[CNT0 + u.aux]; const GAS unsigned* lp = (const GAS unsigned*)plist + (size_t)u.aux * LIST_CAP;
#pragma unroll
        for (int h = 0; h < 2; ++h)
#pragma unroll
            for (int i = 0; i < 2; ++i) { int ridx = u.pm * 256 + h * 128 + R[i]; ridx = ridx < n ? ridx : n - 1; o[h][i] = lp[ridx]; } }
    __device__ __forceinline__ void aoff_fin(const GUnit& u, unsigned (&o)[2][2], const int (&C)[2]) const {
#pragma unroll
        for (int h = 0; h < 2; ++h)
#pragma unroll
            for (int i = 0; i < 2; ++i) { const unsigned e = o[h][i], slot = (e >> 31) ^ (unsigned)u.seg, tk = e & 0x7fffffffu; o[h][i] = ((slot * (unsigned)MTOK + tk) * (unsigned)K + (unsigned)C[i]) * 2u; } }
    __device__ __forceinline__ void aoff(const GUnit& u, const int (&R)[2], const int (&C)[2], unsigned (&o)[2][2]) const { aoff_raw(u, R, C, o); aoff_fin(u, o, C); }
};

template <bool I8, bool QUAD> struct EpiInProj {
    static constexpr bool SEG2 = false;
    const LAS f32x4* ropeL;
    unsigned char* ws; unsigned char* outb;
    __device__ __forceinline__ void operator()(f32x4 (&acc)[2][2][4][2], const GUnit& u, int wr, int wc, int fr, int fq) const {
        { const int l_ = mk_lane(); fr = l_ & 15; fq = l_ >> 4; }
        const int pn = u.pn, row0 = u.pm * 256 + wr * 64 + fr;
        unsigned char* ws = this->ws; unsigned char* outb = this->outb; asm volatile("" : "+s"(ws), "+s"(outb));
        const GAS float* rstd1 = (const GAS float*)(ws + (I8 ? WS_RSTD1Q : WS_RSTD1)); const GAS f32x2* rope = (const GAS f32x2*)(ws + WS_ROPE); const GAS float* lbv = (const GAS float*)(ws + WS_LBV);
        GAS bf16_t* Q = (GAS bf16_t*)(ws + WS_Q); GAS bf16_t* Kb = (GAS bf16_t*)(ws + WS_K); GAS bf16_t* Vb = (GAS bf16_t*)(ws + WS_V);
        GAS bf16_t* QEF = (GAS bf16_t*)(ws + WS_QEF); GAS bf16_t* KEF = (GAS bf16_t*)(ws + WS_KEF); GAS bf16_t* QEB = (GAS bf16_t*)(ws + WS_QEB); GAS bf16_t* KEB = (GAS bf16_t*)(ws + WS_KEB); GAS bf16_t* VH = (GAS bf16_t*)(ws + WS_VH);
        GAS float* VEC = (GAS float*)(ws + WS_VEC);
        if (I8) { f32x4 sw[2][2]; const GAS float* swp = (const GAS float*)(ws + WS_SWIN) + 256 * pn + 32 * wc + 8 * fq;
#pragma unroll
            for (int bj = 0; bj < 2; ++bj)
#pragma unroll
                for (int n = 0; n < 2; ++n) sw[bj][n] = *(const GAS f32x4*)(swp + 128 * bj + 4 * n);
            asm volatile("" : "+v"(sw[0][0]), "+v"(sw[0][1]), "+v"(sw[1][0]), "+v"(sw[1][1]));
#pragma unroll
            for (int ai = 0; ai < 2; ++ai)
#pragma unroll
                for (int bj = 0; bj < 2; ++bj)
#pragma unroll
                    for (int m = 0; m < 4; ++m)
#pragma unroll
                        for (int n = 0; n < 2; ++n)
#pragma unroll
                            for (int i = 0; i < 4; ++i) acc[ai][bj][m][n][i] = (float)__float_as_int(acc[ai][bj][m][n][i]) * sw[bj][n][i]; __builtin_amdgcn_sched_barrier(0); }
        float rsv[2][4];
#pragma unroll
        for (int ai = 0; ai < 2; ++ai)
#pragma unroll
            for (int m = 0; m < 4; ++m) rsv[ai][m] = rstd1[row0 + ai * 128 + m * 16];
        asm volatile("" : "+v"(rsv[0][0]), "+v"(rsv[0][1]), "+v"(rsv[0][2]), "+v"(rsv[0][3]), "+v"(rsv[1][0]), "+v"(rsv[1][1]), "+v"(rsv[1][2]), "+v"(rsv[1][3]));
        if (!QUAD && pn <= 2) {
            const bool isq = pn < 2, isk = (pn == 2) && (wc < 2);
            if (isq || isk) {
                const GAS float* gn = (const GAS float*)(ws + WS_QKN) + (isq ? 0 : 64); float g[2][2][4];
#pragma unroll
                for (int bj = 0; bj < 2; ++bj)
#pragma unroll
                    for (int n = 0; n < 2; ++n) { const f32x4 t = *(const GAS f32x4*)(gn + 32 * bj + 8 * fq + 4 * n); g[bj][n][0] = t[0]; g[bj][n][1] = t[1]; g[bj][n][2] = t[2]; g[bj][n][3] = t[3]; }
                const float osc = isq ? C2 : 1.0f;
#pragma unroll
                for (int ai = 0; ai < 2; ++ai) {
#pragma unroll
                    for (int m = 0; m < 4; ++m) {
                        const int row = row0 + ai * 128 + m * 16; const float rs = rsv[ai][m];
                        f32x4 v[2][2]; float ss = 0.f;
#pragma unroll
                        for (int bj = 0; bj < 2; ++bj)
#pragma unroll
                            for (int n = 0; n < 2; ++n) { v[bj][n] = acc[ai][bj][m][n] * rs; const f32x4 t = v[bj][n]; ss += (t[0] * t[0] + t[1] * t[1]) + (t[2] * t[2] + t[3] * t[3]); }
                        ss += __shfl_xor(ss, 16); ss += __shfl_xor(ss, 32);
                        const float rn = 1.0f / sqrtf(ss * (1.0f / 64.0f) + EPS) ;
                        const int t_ = row & (SEQ - 1);
#pragma unroll
                        for (int bj = 0; bj < 2; ++bj) {
                            const int pos = bj ? (t_ & 63) : (t_ >> 6); unsigned w[4];
#pragma unroll
                            for (int n = 0; n < 2; ++n) {
                                const f32x4 cs = ropeL[pos * 8 + 2 * fq + n];
                                const float a0 = v[bj][n][0] * rn * g[bj][n][0], b0 = v[bj][n][1] * rn * g[bj][n][1];
                                const float a1 = v[bj][n][2] * rn * g[bj][n][2], b1 = v[bj][n][3] * rn * g[bj][n][3];
                                const float o0 = (a0 * cs[0] - b0 * cs[1]) * osc, o1 = (a0 * cs[1] + b0 * cs[0]) * osc;
                                const float o2 = (a1 * cs[2] - b1 * cs[3]) * osc, o3 = (a1 * cs[3] + b1 * cs[2]) * osc;
                                w[2 * n] = cvtpk(o0, o1); w[2 * n + 1] = cvtpk(o2, o3);
                            }
                            const u32x4 ww = {w[0], w[1], w[2], w[3]};
                            if (isq) *(GAS u32x4*)(Q + (size_t)row * 512 + 256 * pn + 64 * wc + 32 * bj + 8 * fq) = ww;
                            else     *(GAS u32x4*)(Kb + (size_t)row * 128 + 64 * wc + 32 * bj + 8 * fq) = ww;
                        }
                    }
                }
            } else {
#pragma unroll
                for (int ai = 0; ai < 2; ++ai)
#pragma unroll
                    for (int m = 0; m < 4; ++m) { const int row = row0 + ai * 128 + m * 16; const float rs = rsv[ai][m];
#pragma unroll
                        for (int bj = 0; bj < 2; ++bj) { const f32x4 x0 = acc[ai][bj][m][0] * rs, x1 = acc[ai][bj][m][1] * rs;
                            const u32x4 ww = {cvtpk(x0[0], x0[1]), cvtpk(x0[2], x0[3]), cvtpk(x1[0], x1[1]), cvtpk(x1[2], x1[3])};
                            *(GAS u32x4*)(Vb + (size_t)row * 128 + 64 * (wc - 2) + 32 * bj + 8 * fq) = ww; } }
            }
        } else if (QUAD) {
            const int ch0 = 64 * (pn - 3) + 16 * wc + 4 * fq;
            const int l0 = fq << 4, l15 = l0 | 15;
#pragma unroll
            for (int ai = 0; ai < 2; ++ai)
#pragma unroll
                for (int cp = 0; cp < 2; ++cp) {
                    const int rlo = row0 + ai * 128 + (2 * cp) * 16, rhi = rlo + 16;
                    const float rs_lo = rsv[ai][2 * cp], rs_hi = rsv[ai][2 * cp + 1];
                    const LAS float* lbL = (const LAS float*)(ropeL + 1024); const f32x4 lbf4 = *(const LAS f32x4*)(lbL + ch0), lbb4 = *(const LAS f32x4*)(lbL + 512 + ch0);
                    unsigned wqf[2][2], wkf[2][2], wqb[2][2], wkb[2][2], wv[2][2];
                    f32x4 eref_f4, g_f4, eref_b4, g_b4;
#pragma unroll
                    for (int ip = 0; ip < 2; ++ip) {
                        float oqf[2][2], okf[2][2], oqb[2][2], okb[2][2], ov[2][2];
#pragma unroll
                        for (int ii = 0; ii < 2; ++ii) {
                            const int i = 2 * ip + ii;
                            const float omf = 1.0f - lbf4[i], omb = 1.0f - lbb4[i];
                            const float hq_lo = acc[ai][0][2 * cp][0][i] * rs_lo, hq_hi = acc[ai][0][2 * cp + 1][0][i] * rs_hi;
                            const float zf_lo = acc[ai][0][2 * cp][1][i] * rs_lo, zf_hi = acc[ai][0][2 * cp + 1][1][i] * rs_hi;
                            const float zb_lo = acc[ai][1][2 * cp][0][i] * rs_lo, zb_hi = acc[ai][1][2 * cp + 1][0][i] * rs_hi;
                            ov[0][ii] = acc[ai][1][2 * cp][1][i] * rs_lo; ov[1][ii] = acc[ai][1][2 * cp + 1][1][i] * rs_hi;
                            const float q_lo = siluf_(hq_lo) * HGRN_SCALE, q_hi = siluf_(hq_hi) * HGRN_SCALE;
                            const float kf_lo = omf * fast_rcp(1.0f + fast_exp(zf_lo)), kf_hi = omf * fast_rcp(1.0f + fast_exp(zf_hi));
                            const float kb_lo = omb * fast_rcp(1.0f + fast_exp(zb_lo)), kb_hi = omb * fast_rcp(1.0f + fast_exp(zb_hi));
                            const float ff_lo = 1.0f - kf_lo, ff_hi = 1.0f - kf_hi, fb_lo = 1.0f - kb_lo, fb_hi = 1.0f - kb_hi;
                            float IP = (fr == 0) ? 1.0f : ff_hi;
                            float IS = ff_lo;
                            float PB = (fr == 15) ? 1.0f : fb_lo;
                            float IH = fb_hi;
                            float ES = 1.0f, EH = 1.0f;
                            asm volatile("s_nop 1\n\t"
                                "v_mul_f32_dpp %0, %0, %0 row_shr:1 row_mask:0xf bank_mask:0xf\n\tv_mul_f32_dpp %1, %1, %1 row_shl:1 row_mask:0xf bank_mask:0xf\n\tv_mul_f32_dpp %2, %2, %2 row_shl:1 row_mask:0xf bank_mask:0xf\n\tv_mul_f32_dpp %3, %3, %3 row_shr:1 row_mask:0xf bank_mask:0xf\n\t"
                                "v_mul_f32_dpp %0, %0, %0 row_shr:2 row_mask:0xf bank_mask:0xf\n\tv_mul_f32_dpp %1, %1, %1 row_shl:2 row_mask:0xf bank_mask:0xf\n\tv_mul_f32_dpp %2, %2, %2 row_shl:2 row_mask:0xf bank_mask:0xf\n\tv_mul_f32_dpp %3, %3, %3 row_shr:2 row_mask:0xf bank_mask:0xf\n\t"
                                "v_mul_f32_dpp %0, %0, %0 row_shr:4 row_mask:0xf bank_mask:0xf\n\tv_mul_f32_dpp %1, %1, %1 row_shl:4 row_mask:0xf bank_mask:0xf\n\tv_mul_f32_dpp %2, %2, %2 row_shl:4 row_mask:0xf bank_mask:0xf\n\tv_mul_f32_dpp %3, %3, %3 row_shr:4 row_mask:0xf bank_mask:0xf\n\t"
                                "v_mul_f32_dpp %0, %0, %0 row_shr:8 row_mask:0xf bank_mask:0xf\n\tv_mul_f32_dpp %1, %1, %1 row_shl:8 row_mask:0xf bank_mask:0xf\n\tv_mul_f32_dpp %2, %2, %2 row_shl:8 row_mask:0xf bank_mask:0xf\n\tv_mul_f32_dpp %3, %3, %3 row_shr:8 row_mask:0xf bank_mask:0xf\n\t"
                                "s_nop 0\n\tv_mov_b32_dpp %4, %1 row_shl:1 row_mask:0xf bank_mask:0xf\n\tv_mov_b32_dpp %5, %3 row_shr:1 row_mask:0xf bank_mask:0xf\n\ts_nop 0"
                                : "+v"(IP), "+v"(IS), "+v"(PB), "+v"(IH), "+v"(ES), "+v"(EH));
                            const float hi0 = __shfl(ff_hi, l0);
                            const float Qf = ES * hi0;
                            oqf[0][ii] = q_lo * fast_rcp(Qf); okf[0][ii] = kf_lo * Qf;
                            oqf[1][ii] = q_hi * IP;           okf[1][ii] = kf_hi * fast_rcp(IP);
                            eref_f4[i] = IS * hi0;
                            g_f4[i] = IP;
                            const float lo15 = __shfl(fb_lo, l15);
                            const float Qb = EH * lo15;
                            oqb[0][ii] = q_lo * PB;           okb[0][ii] = kb_lo * fast_rcp(PB);
                            oqb[1][ii] = q_hi * fast_rcp(Qb); okb[1][ii] = kb_hi * Qb;
                            g_b4[i] = PB;
                            eref_b4[i] = IH * lo15;
                        }
#pragma unroll
                        for (int hl = 0; hl < 2; ++hl) { wqf[hl][ip] = cvtpk(oqf[hl][0], oqf[hl][1]); wkf[hl][ip] = cvtpk(okf[hl][0], okf[hl][1]);
                            wqb[hl][ip] = cvtpk(oqb[hl][0], oqb[hl][1]); wkb[hl][ip] = cvtpk(okb[hl][0], okb[hl][1]); wv[hl][ip] = cvtpk(ov[hl][0], ov[hl][1]); }
                    }
#pragma unroll
                    for (int hl = 0; hl < 2; ++hl) { const size_t o = (size_t)(hl ? rhi : rlo) * 512 + ch0;
                        *(GAS u32x2*)(QEF + o) = (u32x2){wqf[hl][0], wqf[hl][1]}; *(GAS u32x2*)(KEF + o) = (u32x2){wkf[hl][0], wkf[hl][1]};
                        *(GAS u32x2*)(QEB + o) = (u32x2){wqb[hl][0], wqb[hl][1]}; *(GAS u32x2*)(KEB + o) = (u32x2){wkb[hl][0], wkb[hl][1]};
                        *(GAS u32x2*)(VH + o) = (u32x2){wv[hl][0], wv[hl][1]}; }
                    const size_t vo = (size_t)(rlo >> 5) * 512 + ch0;
                    if (fr == 0)  { *(GAS f32x4*)(VEC + 0 * (size_t)2048 * 512 + vo) = eref_f4; *(GAS f32x4*)(VEC + 3 * (size_t)2048 * 512 + vo) = g_b4; }
                    if (fr == 15) { *(GAS f32x4*)(VEC + 1 * (size_t)2048 * 512 + vo) = g_f4;    *(GAS f32x4*)(VEC + 2 * (size_t)2048 * 512 + vo) = eref_b4; }
                    __builtin_amdgcn_sched_barrier(0);
                }
        } else {
            if (pn <= 12) {
                GAS bf16_t* dst = (GAS bf16_t*)(ws + WS_OG); const int cb = 256 * (pn - 11);
#pragma unroll
                for (int ai = 0; ai < 2; ++ai)
#pragma unroll
                    for (int m = 0; m < 4; ++m) { const int row = row0 + ai * 128 + m * 16; const float rs = rsv[ai][m];
#pragma unroll
                        for (int bj = 0; bj < 2; ++bj) { const f32x4 x0 = acc[ai][bj][m][0] * rs, x1 = acc[ai][bj][m][1] * rs;
                            const u32x4 ww = {cvtpk(x0[0], x0[1]), cvtpk(x0[2], x0[3]), cvtpk(x1[0], x1[1]), cvtpk(x1[2], x1[3])};
                            *(GAS u32x4*)(dst + (size_t)row * 512 + cb + 128 * bj + 32 * wc + 8 * fq) = ww; } }
            } else {
                GAS unsigned char* GAB = (GAS unsigned char*)outb; const int cb = 128 * (pn - 13) + 32 * wc + 8 * fq;
#pragma unroll
                for (int ai = 0; ai < 2; ++ai)
#pragma unroll
                    for (int m = 0; m < 4; ++m) { const int row = row0 + ai * 128 + m * 16; const float rs = rsv[ai][m] * -1.4426950408889634f;
                        u32x4 w = {0u, 0u, 0u, 0u};
#pragma unroll
                        for (int n = 0; n < 2; ++n)
#pragma unroll
                            for (int i = 0; i < 4; ++i) { const float ea = 1.0f + __builtin_amdgcn_exp2f(acc[ai][0][m][n][i] * rs), eb = 1.0f + __builtin_amdgcn_exp2f(acc[ai][1][m][n][i] * rs);
                                const float qa = rintf(255.0f * fast_rcp(ea)), qb = fmaxf(rintf(255.0f * fast_rcp(eb)), 1.0f); const int c = 4 * n + i;
                                w[c >> 1] = __builtin_amdgcn_cvt_pk_u8_f32(qa, 2 * (c & 1), w[c >> 1]); w[c >> 1] = __builtin_amdgcn_cvt_pk_u8_f32(qb, 2 * (c & 1) + 1, w[c >> 1]); }
                        *(GAS u32x4*)(GAB + ((size_t)row * 1024 + cb) * 2) = w; }
            }
        }
    }
    __device__ __forceinline__ void mid(f32x4 (&)[2][2][4][2], const GUnit&, int, int, int, int) const {}
};

__device__ __forceinline__ float ubf0(unsigned x) { return (float)(x & 0xffu); }
__device__ __forceinline__ float ubf1(unsigned x) { return (float)((x >> 8) & 0xffu); }
__device__ __forceinline__ float ubf2(unsigned x) { return (float)((x >> 16) & 0xffu); }
__device__ __forceinline__ float ubf3(unsigned x) { return (float)(x >> 24); }
struct EpiMerge {
    static constexpr bool SEG2 = true;
    const unsigned char* GAB; bf16_t* MG;
    __device__ __forceinline__ void mid(f32x4 (&acc)[2][2][4][2], const GUnit& u, int wr, int wc, int fr, int fq) const {
        const unsigned char* G_ = this->GAB; asm volatile("" : "+s"(G_)); const GAS unsigned char* G = (const GAS unsigned char*)G_;
        const int row0 = u.pm * 256 + wr * 64 + fr, col0 = u.pn * 256 + wc * 32 + 8 * fq;
#pragma unroll
        for (int ai = 0; ai < 2; ++ai) {
            u32x4 av[4][2];
#pragma unroll
            for (int m = 0; m < 4; ++m) { const unsigned ro = (unsigned)((row0 + ai * 128 + m * 16) * 1024 + col0) * 2u;
#pragma unroll
                for (int bj = 0; bj < 2; ++bj) av[m][bj] = *(const GAS u32x4*)(G + (ro + 256u * bj)); }
            __builtin_amdgcn_sched_barrier(0);
#pragma unroll
            for (int m = 0; m < 4; ++m)
#pragma unroll
                for (int bj = 0; bj < 2; ++bj) { const u32x4 a = av[m][bj];
#pragma unroll
                    for (int n = 0; n < 2; ++n) {
                        const f32x4 r = {ubf0(a[2 * n]) * fast_rcp(ubf1(a[2 * n])), ubf2(a[2 * n]) * fast_rcp(ubf3(a[2 * n])),
                                         ubf0(a[2 * n + 1]) * fast_rcp(ubf1(a[2 * n + 1])), ubf2(a[2 * n + 1]) * fast_rcp(ubf3(a[2 * n + 1]))};
                        acc[ai][bj][m][n] *= r; } }
        }
    }
    __device__ __forceinline__ void operator()(f32x4 (&acc)[2][2][4][2], const GUnit& u, int wr, int wc, int fr, int fq) const {
        const unsigned char* G_ = this->GAB; bf16_t* MG_ = this->MG; asm volatile("" : "+s"(G_), "+s"(MG_)); const GAS unsigned char* G = (const GAS unsigned char*)G_; GAS bf16_t* MG = (GAS bf16_t*)MG_;
        const int row0 = u.pm * 256 + wr * 64 + fr, col0 = u.pn * 256 + wc * 32 + 8 * fq;
        u32x4 bv[2][4][2];
#pragma unroll
        for (int ai = 0; ai < 2; ++ai)
#pragma unroll
            for (int m = 0; m < 4; ++m) { const unsigned ro = (unsigned)((row0 + ai * 128 + m * 16) * 1024 + col0) * 2u;
#pragma unroll
                for (int bj = 0; bj < 2; ++bj) bv[ai][m][bj] = *(const GAS u32x4*)(G + (ro + 256u * bj)); }
        __builtin_amdgcn_sched_barrier(0);
        constexpr float K255 = 1.0f / 255.0f;
#pragma unroll
        for (int ai = 0; ai < 2; ++ai)
#pragma unroll
            for (int m = 0; m < 4; ++m) { const unsigned ro = (unsigned)((row0 + ai * 128 + m * 16) * 1024 + col0) * 2u;
#pragma unroll
                for (int bj = 0; bj < 2; ++bj) { const u32x4 b = bv[ai][m][bj];
                    const f32x4 x0 = acc[ai][bj][m][0] * K255, x1 = acc[ai][bj][m][1] * K255;
                    const u32x4 ww = {cvtpk(x0[0] * ubf1(b[0]), x0[1] * ubf3(b[0])), cvtpk(x0[2] * ubf1(b[1]), x0[3] * ubf3(b[1])),
                                      cvtpk(x1[0] * ubf1(b[2]), x1[1] * ubf3(b[2])), cvtpk(x1[2] * ubf1(b[3]), x1[3] * ubf3(b[3]))};
                    *(GAS u32x4*)((GAS char*)MG + (ro + 256u * bj)) = ww; } }
    }
};

struct EpiX1 {
    static constexpr bool SEG2 = false;
    const float* X; bf16_t* X1B; float* SSQ; float* AMX;
    __device__ __forceinline__ void mid(f32x4 (&)[2][2][4][2], const GUnit&, int, int, int, int) const {}
    __device__ __forceinline__ void operator()(f32x4 (&acc)[2][2][4][2], const GUnit& u, int wr, int wc, int fr, int fq) const {
        const float* X_ = this->X; bf16_t* X1B_ = this->X1B; float* SSQ_ = this->SSQ; float* RM_ = this->AMX; asm volatile("" : "+s"(X_), "+s"(X1B_), "+s"(SSQ_), "+s"(RM_));
        const GAS char* X = (const GAS char*)X_; GAS char* X1B = (GAS char*)X1B_; GAS char* SSQ = (GAS char*)SSQ_; GAS char* AMX = (GAS char*)RM_;
        const int row0 = u.pm * 256 + wr * 64 + fr, col0 = u.pn * 256 + wc * 32 + 8 * fq;
        f32x4 xa[4][2][2], xb[4][2][2];
#pragma unroll
        for (int m = 0; m < 4; ++m) { const unsigned ro = (unsigned)((row0 + m * 16) * 1024 + col0) * 4u;
#pragma unroll
            for (int bj = 0; bj < 2; ++bj) { xa[m][bj][0] = *(const GAS f32x4*)(X + (ro + 512u * bj)); xa[m][bj][1] = *(const GAS f32x4*)(X + (ro + 512u * bj + 16u)); } }
        __builtin_amdgcn_sched_barrier(0);
        u32x4 pk[4][2]; float ssv[4], mxv[4];
#define X1_HALF(AI, XV) do { _Pragma("unroll") for (int m = 0; m < 4; ++m) { float ss = 0.f, mx = 0.f; \
            _Pragma("unroll") for (int bj = 0; bj < 2; ++bj) { const f32x4 v0 = XV[m][bj][0] + acc[AI][bj][m][0], v1 = XV[m][bj][1] + acc[AI][bj][m][1]; \
                ss += (v0[0] * v0[0] + v0[1] * v0[1]) + (v0[2] * v0[2] + v0[3] * v0[3]) + (v1[0] * v1[0] + v1[1] * v1[1]) + (v1[2] * v1[2] + v1[3] * v1[3]); \
                mx = fmaxf(fmaxf(fmaxf(fmaxf(mx, fabsf(v0[0])), fmaxf(fabsf(v0[1]), fabsf(v0[2]))), fmaxf(fmaxf(fabsf(v0[3]), fabsf(v1[0])), fmaxf(fabsf(v1[1]), fabsf(v1[2])))), fabsf(v1[3])); \
                pk[m][bj] = (u32x4){cvtpk(v0[0], v0[1]), cvtpk(v0[2], v0[3]), cvtpk(v1[0], v1[1]), cvtpk(v1[2], v1[3])}; } \
            ss += __shfl_xor(ss, 16); ss += __shfl_xor(ss, 32); mx = fmaxf(mx, __shfl_xor(mx, 16)); mx = fmaxf(mx, __shfl_xor(mx, 32)); ssv[m] = ss; mxv[m] = mx; } } while (0)
#define X1_STORE(AI) do { _Pragma("unroll") for (int m = 0; m < 4; ++m) { const int row = row0 + AI * 128 + m * 16; const unsigned ro = (unsigned)(row * 1024 + col0) * 2u; \
            _Pragma("unroll") for (int bj = 0; bj < 2; ++bj) *(GAS u32x4*)(X1B + (ro + 256u * bj)) = pk[m][bj]; \
            if (fq == 0) { const unsigned po = (unsigned)(row * 16 + 4 * u.pn + wc) * 4u; *(GAS float*)(SSQ + po) = ssv[m]; *(GAS float*)(AMX + po) = mxv[m]; } } } while (0)
        X1_HALF(0, xa);
        __builtin_amdgcn_sched_barrier(0);
#pragma unroll
        for (int m = 0; m < 4; ++m) { const unsigned ro = (unsigned)((row0 + 128 + m * 16) * 1024 + col0) * 4u;
#pragma unroll
            for (int bj = 0; bj < 2; ++bj) { xb[m][bj][0] = *(const GAS f32x4*)(X + (ro + 512u * bj)); xb[m][bj][1] = *(const GAS f32x4*)(X + (ro + 512u * bj + 16u)); } }
        __builtin_amdgcn_sched_barrier(0);
        X1_STORE(0);
        __builtin_amdgcn_sched_barrier(0);
        X1_HALF(1, xb);
        X1_STORE(1);
#undef X1_HALF
#undef X1_STORE
    }
};

struct EpiMoeUp {
    static constexpr bool SEG2 = false;
    const LAS int* tab; const int* lists; const float* rstd2; const u32x4* tok; bf16_t* HID; const float* SX1; const float* SWGU;
    __device__ __forceinline__ void mid(f32x4 (&)[2][2][4][2], const GUnit&, int, int, int, int) const {}
    __device__ __forceinline__ void operator()(f32x4 (&acc)[2][2][4][2], const GUnit& u, int wr, int wc, int fr, int fq) const {
        const int* lists_ = this->lists; const float* rstd2_ = this->rstd2; const u32x4* tok_ = this->tok; bf16_t* HID_ = this->HID; const float* SX_ = this->SX1; const float* SW_ = this->SWGU; asm volatile("" : "+s"(lists_), "+s"(rstd2_), "+s"(tok_), "+s"(HID_), "+s"(SX_), "+s"(SW_));
        const GAS int* lists = (const GAS int*)lists_; const GAS float* rstd2 = (const GAS float*)rstd2_; const GAS u32x4* tok = (const GAS u32x4*)tok_; GAS bf16_t* HID = (GAS bf16_t*)HID_; const GAS float* SX1 = (const GAS float*)SX_; const GAS float* SWGU = (const GAS float*)SW_;
        const int li = u.aux, slot = li & 1, n = tab[80 + li]; const GAS int* lp = lists + (size_t)li * LIST_CAP;
        const int r0 = u.pm * 256 + wr * 64 + fr, hc0 = 128 * u.pn + 32 * wc + 8 * fq;
        int tk[2][4];
#pragma unroll
        for (int ai = 0; ai < 2; ++ai)
#pragma unroll
            for (int m = 0; m < 4; ++m) { const int ridx = r0 + ai * 128 + m * 16; tk[ai][m] = lp[ridx < n ? ridx : n - 1]; }
        float rsv[2][4], wv[2][4];
#pragma unroll
        for (int ai = 0; ai < 2; ++ai)
#pragma unroll
            for (int m = 0; m < 4; ++m) { const GAS unsigned* tp = (const GAS unsigned*)tok + (size_t)tk[ai][m] * 4; rsv[ai][m] = __uint_as_float(tp[0]); wv[ai][m] = __uint_as_float(tp[2 + slot]); }
        f32x4 swg[2], swu[2];
        { const GAS float* swp = SWGU + (size_t)(li >> 1) * 1024 + 256 * u.pn + 32 * wc + 8 * fq;
#pragma unroll
          for (int nn = 0; nn < 2; ++nn) { swg[nn] = *(const GAS f32x4*)(swp + 4 * nn); swu[nn] = *(const GAS f32x4*)(swp + 128 + 4 * nn); } }
        asm volatile("" : "+v"(swg[0]), "+v"(swg[1]), "+v"(swu[0]), "+v"(swu[1]));
        asm volatile("" : "+v"(rsv[0][0]), "+v"(rsv[0][1]), "+v"(rsv[0][2]), "+v"(rsv[0][3]), "+v"(rsv[1][0]), "+v"(rsv[1][1]), "+v"(rsv[1][2]), "+v"(rsv[1][3]));
        asm volatile("" : "+v"(wv[0][0]), "+v"(wv[0][1]), "+v"(wv[0][2]), "+v"(wv[0][3]), "+v"(wv[1][0]), "+v"(wv[1][1]), "+v"(wv[1][2]), "+v"(wv[1][3]));
#pragma unroll
        for (int ai = 0; ai < 2; ++ai)
#pragma unroll
            for (int m = 0; m < 4; ++m) { const int ridx = r0 + ai * 128 + m * 16;
                if (ridx < n) { const int t = tk[ai][m]; const float rs = rsv[ai][m], w = wv[ai][m];
                    f32x4 h0, h1;
#pragma unroll
                    for (int i = 0; i < 4; ++i) { const float g0 = (float)__float_as_int(acc[ai][0][m][0][i]) * (rs * swg[0][i]), u0 = (float)__float_as_int(acc[ai][1][m][0][i]) * (rs * swu[0][i]), g1 = (float)__float_as_int(acc[ai][0][m][1][i]) * (rs * swg[1][i]), u1 = (float)__float_as_int(acc[ai][1][m][1][i]) * (rs * swu[1][i]);
                        h0[i] = siluf_(g0) * u0 * w; h1[i] = siluf_(g1) * u1 * w; }
                    const u32x4 ww = {cvtpk(h0[0], h0[1]), cvtpk(h0[2], h0[3]), cvtpk(h1[0], h1[1]), cvtpk(h1[2], h1[3])};
                    *(GAS u32x4*)(HID + ((size_t)slot * MTOK + t) * 512 + hc0) = ww; } }
    }
};
template <int SLOT> struct EpiMoeDown {
    static constexpr bool SEG2 = false;
    const LAS int* tab; const int* lists; float* OUT; bf16_t* Y0; const bf16_t* X1B;
    __device__ __forceinline__ void mid(f32x4 (&)[2][2][4][2], const GUnit&, int, int, int, int) const {}
    __device__ __forceinline__ void operator()(f32x4 (&acc)[2][2][4][2], const GUnit& u, int wr, int wc, int fr, int fq) const {
        const int* lists_ = this->lists; float* OUT_ = this->OUT; bf16_t* Y0_ = this->Y0; const bf16_t* X1B_ = this->X1B; asm volatile("" : "+s"(lists_), "+s"(OUT_), "+s"(Y0_), "+s"(X1B_));
        const GAS int* lists = (const GAS int*)lists_; GAS float* OUT = (GAS float*)OUT_; GAS bf16_t* Y0 = (GAS bf16_t*)Y0_; const GAS bf16_t* X1B = (const GAS bf16_t*)X1B_;
        const int li = u.aux, n = tab[80 + li]; const GAS int* lp = lists + (size_t)li * LIST_CAP;
        const int r0 = u.pm * 256 + wr * 64 + fr, col0 = 256 * u.pn + 32 * wc + 8 * fq;
        int tk[2][4];
#pragma unroll
        for (int ai = 0; ai < 2; ++ai)
#pragma unroll
            for (int m = 0; m < 4; ++m) { const int ridx = r0 + ai * 128 + m * 16; tk[ai][m] = lp[ridx < n ? ridx : n - 1]; }
        asm volatile("" : "+v"(tk[0][0]), "+v"(tk[0][1]), "+v"(tk[0][2]), "+v"(tk[0][3]), "+v"(tk[1][0]), "+v"(tk[1][1]), "+v"(tk[1][2]), "+v"(tk[1][3]));
        if (SLOT == 0) {
#pragma unroll
            for (int ai = 0; ai < 2; ++ai)
#pragma unroll
                for (int m = 0; m < 4; ++m) { const int ridx = r0 + ai * 128 + m * 16;
                    if (ridx < n) { GAS bf16_t* yp = Y0 + (size_t)tk[ai][m] * Y0_PITCH + col0;
#pragma unroll
                        for (int bj = 0; bj < 2; ++bj) { const f32x4 x0 = acc[ai][bj][m][0], x1 = acc[ai][bj][m][1];
                            const u32x4 ww = {cvtpk(x0[0], x0[1]), cvtpk(x0[2], x0[3]), cvtpk(x1[0], x1[1]), cvtpk(x1[2], x1[3])}; *(GAS u32x4*)(yp + 128 * bj) = ww; } } }
        } else {
#pragma unroll
            for (int ai = 0; ai < 2; ++ai)
#pragma unroll
                for (int mp = 0; mp < 2; ++mp) {
                    u32x4 av[2][2], yv[2][2];
#pragma unroll
                    for (int mm = 0; mm < 2; ++mm) { const int m = 2 * mp + mm; const GAS bf16_t* xp = X1B + (size_t)tk[ai][m] * 1024 + col0; const GAS bf16_t* yp = Y0 + (size_t)tk[ai][m] * Y0_PITCH + col0;
#pragma unroll
                        for (int bj = 0; bj < 2; ++bj) { av[mm][bj] = *(const GAS u32x4*)(xp + 128 * bj); yv[mm][bj] = *(const GAS u32x4*)(yp + 128 * bj); } }
                    __builtin_amdgcn_sched_barrier(0);
#pragma unroll
                    for (int mm = 0; mm < 2; ++mm) { const int m = 2 * mp + mm; const int ridx = r0 + ai * 128 + m * 16;
                        if (ridx < n) { GAS float* op = OUT + (size_t)tk[ai][m] * 1024 + col0;
#pragma unroll
                            for (int bj = 0; bj < 2; ++bj) { const u32x4 y = yv[mm][bj], xx = av[mm][bj];
                                const f32x4 y0 = {bf_lo(y[0]) + bf_lo(xx[0]), bf_hi(y[0]) + bf_hi(xx[0]), bf_lo(y[1]) + bf_lo(xx[1]), bf_hi(y[1]) + bf_hi(xx[1])};
                                const f32x4 y1 = {bf_lo(y[2]) + bf_lo(xx[2]), bf_hi(y[2]) + bf_hi(xx[2]), bf_lo(y[3]) + bf_lo(xx[3]), bf_hi(y[3]) + bf_hi(xx[3])};
                                *(GAS f32x4*)(op + 128 * bj) = y0 + acc[ai][bj][m][0]; *(GAS f32x4*)(op + 128 * bj + 4) = y1 + acc[ai][bj][m][1]; } } }
                }
        }
    }
};

struct EpiMoeDown2 {
    static constexpr bool SEG2 = true;
    const LAS int* tab; const unsigned* plist; float* OUT; const bf16_t* X1B;
    __device__ __forceinline__ void mid(f32x4 (&)[2][2][4][2], const GUnit&, int, int, int, int) const {}
    __device__ __forceinline__ void operator()(f32x4 (&acc)[2][2][4][2], const GUnit& u, int wr, int wc, int fr, int fq) const {
        const unsigned* pl_ = this->plist; float* OUT_ = this->OUT; const bf16_t* X1B_ = this->X1B; asm volatile("" : "+s"(pl_), "+s"(OUT_), "+s"(X1B_));
        const GAS unsigned* lp = (const GAS unsigned*)pl_ + (size_t)u.aux * LIST_CAP; GAS char* OUT = (GAS char*)OUT_; const GAS char* X1B = (const GAS char*)X1B_;
        const int n = tab[PairOrder::CNT0 + u.aux];
        const int r0 = u.pm * 256 + wr * 64 + fr, col0 = 256 * u.pn + 32 * wc + 8 * fq;
        unsigned ro[2][4];
#pragma unroll
        for (int ai = 0; ai < 2; ++ai)
#pragma unroll
            for (int m = 0; m < 4; ++m) { const int ridx = r0 + ai * 128 + m * 16; const unsigned tk = lp[ridx < n ? ridx : n - 1] & 0x7fffffffu; ro[ai][m] = (tk * 1024u + (unsigned)col0) * 2u; }
        asm volatile("" : "+v"(ro[0][0]), "+v"(ro[0][1]), "+v"(ro[0][2]), "+v"(ro[0][3]), "+v"(ro[1][0]), "+v"(ro[1][1]), "+v"(ro[1][2]), "+v"(ro[1][3]));
        u32x4 xa[4][2], xb[4][2];
#pragma unroll
        for (int m = 0; m < 4; ++m)
#pragma unroll
            for (int bj = 0; bj < 2; ++bj) xa[m][bj] = *(const GAS u32x4*)(X1B + (ro[0][m] + 256u * bj));
        __builtin_amdgcn_sched_barrier(0);
#pragma unroll
        for (int m = 0; m < 4; ++m)
#pragma unroll
            for (int bj = 0; bj < 2; ++bj) xb[m][bj] = *(const GAS u32x4*)(X1B + (ro[1][m] + 256u * bj));
        __builtin_amdgcn_sched_barrier(0);
#define MD2_HALF(AI, XV) do { _Pragma("unroll") for (int m = 0; m < 4; ++m) { const int ridx = r0 + AI * 128 + m * 16; \
            if (ridx < n) { _Pragma("unroll") for (int bj = 0; bj < 2; ++bj) { const u32x4 xx = XV[m][bj]; GAS char* op = OUT + ((size_t)ro[AI][m] * 2 + 512u * bj); \
                *(GAS f32x4*)op = (f32x4){bf_lo(xx[0]), bf_hi(xx[0]), bf_lo(xx[1]), bf_hi(xx[1])} + acc[AI][bj][m][0]; \
                *(GAS f32x4*)(op + 16) = (f32x4){bf_lo(xx[2]), bf_hi(xx[2]), bf_lo(xx[3]), bf_hi(xx[3])} + acc[AI][bj][m][1]; } } } } while (0)
        MD2_HALF(0, xa);
        MD2_HALF(1, xb);
#undef MD2_HALF
    }
};
namespace hg {
constexpr int TILE = 8192, BUF = 3 * TILE + 1024, NBUF = 3, GRP = NBUF * BUF;
static_assert(2 * GRP <= SCAN_LDS_BYTES, "scan ring fits below the LDS control words");
__device__ __forceinline__ unsigned off_b(unsigned row, unsigned ch) { return 256u * row + 16u * (ch ^ (((row & 3) << 2) | ((row >> 2) & 3))); }
__device__ __forceinline__ int crow(int r, int h) { return (r & 3) + 8 * (r >> 2) + 4 * h; }
__device__ __forceinline__ s16x4 trr(const LAS unsigned char* p) { typedef short v4i16 __attribute__((ext_vector_type(4))); return __builtin_bit_cast(s16x4, __builtin_amdgcn_ds_read_tr16_b64_v4i16((LAS v4i16*)p)); }
__device__ __forceinline__ bf16x8 pack8n(const f32x16& x, int s) {
    u32x4 p; p.x = cvtpk(x[8 * s], x[8 * s + 1]); p.y = cvtpk(x[8 * s + 2], x[8 * s + 3]); p.z = cvtpk(x[8 * s + 4], x[8 * s + 5]); p.w = cvtpk(x[8 * s + 6], x[8 * s + 7]);
    return __builtin_bit_cast(bf16x8, p);
}

__device__ __forceinline__ void hgrn_pair(int b, int head, LAS unsigned char* lds, const unsigned char* ws, int wave) {
    int tid_ = wave * 64 + mk_lane(); asm volatile("" : "+v"(tid_));
    const int tid = tid_, lane = tid & 63, r32 = lane & 31, h = lane >> 5; const int wid = __builtin_amdgcn_readfirstlane(tid >> 6);
    const int grp = wid >> 2, w = wid & 3;
    LAS unsigned char* gbase = lds + grp * GRP;
    const bf16_t* QE = (const bf16_t*)(ws + (grp ? WS_QEB : WS_QEF)); const bf16_t* KE = (const bf16_t*)(ws + (grp ? WS_KEB : WS_KEF)); const bf16_t* VH = (const bf16_t*)(ws + WS_VH);
    bf16_t* OD = (bf16_t*)(ws + (grp ? WS_OB : WS_OF));
    const int prow = lane >> 4, pch = lane & 15;
    unsigned so[2];
#pragma unroll
    for (int k = 0; k < 2; ++k) { const int row = 4 * (w + 4 * k) + prow; const int ch = pch ^ (((row & 3) << 2) | ((row >> 2) & 3)); so[k] = (unsigned)(row * 1024 + ch * 16); }
    const size_t colb = (size_t)head * 128 * 2;
#define HG_G16(src_, dst_) do { unsigned keep_; asm volatile("s_mov_b32 %0, m0\n\ts_mov_b32 m0, %2\n\ts_nop 0\n\tglobal_load_lds_dwordx4 %1, off\n\ts_mov_b32 m0, %0" : "=&s"(keep_) : "v"(src_), "s"((unsigned)__builtin_amdgcn_readfirstlane((int)(dst_))) : "memory"); } while (0)
#define HG_G4(src_, dst_) do { unsigned keep_; asm volatile("s_mov_b32 %0, m0\n\ts_mov_b32 m0, %2\n\ts_nop 0\n\tglobal_load_lds_dword %1, off\n\ts_mov_b32 m0, %0" : "=&s"(keep_) : "v"(src_), "s"((unsigned)__builtin_amdgcn_readfirstlane((int)(dst_))) : "memory"); } while (0)
    const unsigned gbase_u = (unsigned)(uintptr_t)gbase;
#define HG_DMA(st_, bi_) do { const int n_ = grp ? 255 - (st_) : (st_); const size_t tb_ = ((size_t)(b * SEQ + n_ * 32) * 512) * 2 + colb; const unsigned bb_ = gbase_u + (unsigned)(bi_); \
        _Pragma("unroll") for (int k_ = 0; k_ < 2; ++k_) { \
            HG_G16((const char*)QE + tb_ + so[k_], bb_ + 0 * TILE + (w + 4 * k_) * 1024); \
            HG_G16((const char*)KE + tb_ + so[k_], bb_ + 1 * TILE + (w + 4 * k_) * 1024); \
            HG_G16((const char*)VH + tb_ + so[k_], bb_ + 2 * TILE + (w + 4 * k_) * 1024); } \
        if (w < 2) { const float* vsrc_ = CV + (size_t)(b * 256 + n_) * 512 + head * 128 + w * 64 + lane; \
          HG_G4(vsrc_, bb_ + 3 * TILE + w * 256); } } while (0)
    const float* CV = (const float*)(ws + WS_CVEC) + (size_t)grp * 2048 * 512;
    { float* CW = (float*)(ws + WS_CVEC); const float* V4 = (const float*)(ws + WS_VEC);
      for (int i0 = tid; i0 < 2 * 256 * 128; i0 += 16 * NWAVES * 64) { float e[16], g[16];
#pragma unroll
          for (int u = 0; u < 16; ++u) { const int idx = i0 + u * NWAVES * 64; const int dir = idx >> 15, n_ = (idx >> 7) & 255, ch = idx & 127;
              const int chunk = dir ? 255 - n_ : n_, prev = dir ? chunk + 1 : chunk - 1; const size_t col = (size_t)head * 128 + ch;
              e[u] = V4[((size_t)(dir ? 2 : 0) * 2048 + b * 256 + chunk) * 512 + col];
              g[u] = (n_ > 0) ? V4[((size_t)(dir ? 3 : 1) * 2048 + b * 256 + prev) * 512 + col] : 1.0f; }
          __builtin_amdgcn_sched_barrier(0);
#pragma unroll
          for (int u = 0; u < 16; ++u) { const int idx = i0 + u * NWAVES * 64; const int dir = idx >> 15, n_ = (idx >> 7) & 255, ch = idx & 127;
              const int chunk = dir ? 255 - n_ : n_; const size_t col = (size_t)head * 128 + ch;
              CW[((size_t)dir * 2048 + b * 256 + chunk) * 512 + col] = e[u] * g[u]; } }
      asm volatile("s_waitcnt vmcnt(0)" ::: "memory"); __syncthreads(); __builtin_amdgcn_fence(__ATOMIC_ACQUIRE, "agent"); asm volatile("s_waitcnt vmcnt(0)" ::: "memory"); __syncthreads(); }
    f32x16 S[4];
#pragma unroll
    for (int T = 0; T < 4; ++T)
#pragma unroll
        for (int r = 0; r < 16; ++r) S[T][r] = 0.f;
    const int q4 = (lane & 15) >> 2, p4 = lane & 3, blk = (lane >> 4) & 1;
    int o_cur = 0, o_nxt = BUF, o_nn = 2 * BUF;
    HG_DMA(0, 0); HG_DMA(1, BUF);
    asm volatile("s_waitcnt vmcnt(6)" ::: "memory"); __builtin_amdgcn_s_barrier(); asm volatile("" ::: "memory");
    for (int st = 0; st < 256; ++st) {
        const int n = grp ? 255 - st : st;
        if (st + 2 < 256) HG_DMA(st + 2, o_nn);
        const LAS unsigned char* bb = gbase + o_cur;
        const LAS unsigned char* qe = bb; const LAS unsigned char* ke = bb + TILE; const LAS unsigned char* vv = bb + 2 * TILE;
        const LAS float* er = (const LAS float*)(bb + 3 * TILE);
        bf16x8 vf[2];
#pragma unroll
        for (int s = 0; s < 2; ++s) { const s16x4 lo = trr(vv + off_b(16 * s + 4 * h + q4, 4 * w + 2 * blk + (p4 >> 1)) + 8 * (p4 & 1)), hi = trr(vv + off_b(16 * s + 8 + 4 * h + q4, 4 * w + 2 * blk + (p4 >> 1)) + 8 * (p4 & 1));
            vf[s] = __builtin_shufflevector(lo, hi, 0, 1, 2, 3, 4, 5, 6, 7); }
#pragma unroll
        for (int T = 0; T < 4; ++T)
#pragma unroll
            for (int gq = 0; gq < 4; ++gq) { const f32x4 cc = *(const LAS f32x4*)(er + 32 * T + 8 * gq + 4 * h);
#pragma unroll
                for (int j = 0; j < 4; ++j) S[T][4 * gq + j] *= cc[j]; }
        f32x16 O;
#pragma unroll
        for (int r = 0; r < 16; ++r) O[r] = 0.f;
#pragma unroll
        for (int T = 0; T < 4; ++T)
#pragma unroll
            for (int s = 0; s < 2; ++s) {
                const bf16x8 sb = pack8n(S[T], s);
                const s16x4 a0 = *(const LAS s16x4*)(qe + off_b(r32, 4 * T + 2 * s) + 8 * h), a1 = *(const LAS s16x4*)(qe + off_b(r32, 4 * T + 2 * s + 1) + 8 * h);
                const bf16x8 af = __builtin_shufflevector(a0, a1, 0, 1, 2, 3, 4, 5, 6, 7);
                O = __builtin_amdgcn_mfma_f32_32x32x16_bf16(af, sb, O, 0, 0, 0);
            }
        f32x16 at;
#pragma unroll
        for (int r = 0; r < 16; ++r) at[r] = 0.f;
#pragma unroll
        for (int kk = 0; kk < 8; ++kk) { const bf16x8 ka = *(const LAS bf16x8*)(ke + off_b(r32, 2 * kk + h)), qb = *(const LAS bf16x8*)(qe + off_b(r32, 2 * kk + h));
            at = __builtin_amdgcn_mfma_f32_32x32x16_bf16(ka, qb, at, 0, 0, 0); }
#pragma unroll
        for (int r = 0; r < 16; ++r) { const int srow = crow(r, h); const bool keepv = grp ? (srow >= r32) : (srow <= r32); at[r] = keepv ? at[r] : 0.f; }
#pragma unroll
        for (int s = 0; s < 2; ++s) { const bf16x8 af = pack8n(at, s); O = __builtin_amdgcn_mfma_f32_32x32x16_bf16(af, vf[s], O, 0, 0, 0); }
#pragma unroll
        for (int T = 0; T < 4; ++T) {
#pragma unroll
            for (int s = 0; s < 2; ++s) { const s16x4 lo = trr(ke + off_b(16 * s + 4 * h + q4, 4 * T + 2 * blk + (p4 >> 1)) + 8 * (p4 & 1)), hi = trr(ke + off_b(16 * s + 8 + 4 * h + q4, 4 * T + 2 * blk + (p4 >> 1)) + 8 * (p4 & 1));
                const bf16x8 kf = __builtin_shufflevector(lo, hi, 0, 1, 2, 3, 4, 5, 6, 7);
                S[T] = __builtin_amdgcn_mfma_f32_32x32x16_bf16(kf, vf[s], S[T], 0, 0, 0); }
        }
        { bf16_t* op = OD + ((size_t)(b * SEQ + n * 32) * 512 + head * 128 + 32 * w + r32);
#pragma unroll
          for (int r = 0; r < 16; ++r) { const unsigned pk = cvtpk(O[r], 0.f); op[(size_t)crow(r, h) * 512] = (bf16_t)(pk & 0xffffu); } }
        if (st + 2 < 256) asm volatile("s_waitcnt vmcnt(22) lgkmcnt(0)" ::: "memory"); else asm volatile("s_waitcnt vmcnt(16) lgkmcnt(0)" ::: "memory");
        __builtin_amdgcn_s_barrier(); asm volatile("" ::: "memory");
        { const int t_ = o_cur; o_cur = o_nxt; o_nxt = o_nn; o_nn = t_; }
    }
    asm volatile("s_waitcnt vmcnt(0)" ::: "memory");
#undef HG_DMA
#undef HG_G16
#undef HG_G4
}
}

__device__ __forceinline__ void hgrn_finalize_bh(int b, int head, int row_lo, int row_hi, int wave, const unsigned char* ws) {
    const int lane = mk_lane(), sub = lane >> 4, l16 = lane & 15;
    const GAS bf16_t* OFW = (const GAS bf16_t*)(ws + WS_OF); const GAS bf16_t* OBW = (const GAS bf16_t*)(ws + WS_OB); GAS bf16_t* OG = (GAS bf16_t*)(ws + WS_OG);
    for (int r0 = row_lo + wave * 4; r0 < row_hi; r0 += 4 * NWAVES * 4) {
        u32x4 a[4], bb[4], g[4]; size_t o[4];
#pragma unroll
        for (int k = 0; k < 4; ++k) { o[k] = ((size_t)b * SEQ + r0 + k * NWAVES * 4 + sub) * 512 + head * 128 + l16 * 8;
            a[k] = *(const GAS u32x4*)(OFW + o[k]); bb[k] = *(const GAS u32x4*)(OBW + o[k]); g[k] = *(const GAS u32x4*)(OG + o[k]); }
        __builtin_amdgcn_sched_barrier(0);
#pragma unroll
        for (int k = 0; k < 4; ++k) {
            float v[8]; float ss = 0.f;
#pragma unroll
            for (int i = 0; i < 4; ++i) { v[2 * i] = bf_lo(a[k][i]) + bf_lo(bb[k][i]); v[2 * i + 1] = bf_hi(a[k][i]) + bf_hi(bb[k][i]); ss += v[2 * i] * v[2 * i] + v[2 * i + 1] * v[2 * i + 1]; }
            ss += __shfl_xor(ss, 1); ss += __shfl_xor(ss, 2); ss += __shfl_xor(ss, 4); ss += __shfl_xor(ss, 8);
            const float rn = 1.0f / sqrtf(ss * (1.0f / 128.0f) + EPS);
            u32x4 w;
#pragma unroll
            for (int i = 0; i < 4; ++i) { const float g0 = bf_lo(g[k][i]), g1 = bf_hi(g[k][i]); w[i] = cvtpk(v[2 * i] * rn * siluf_(g0), v[2 * i + 1] * rn * siluf_(g1)); }
            *(GAS u32x4*)(OG + o[k]) = w; }
    }
}

__device__ __forceinline__ void router_phase(Frame& F, int g0, int g1) {
    const int lane = mk_lane();
    LAS float* scr = (LAS float*)(F.lds + RING_OFF + F.wave * 4096);
    const bf16_t* X1 = (const bf16_t*)(F.ws + WS_X1B); const bf16_t* Wr = (const bf16_t*)(F.ws + WS_WR); const float* SSQ = (const float*)(F.ws + WS_SSQ);
    float* rstd2 = (float*)(F.ws + WS_RSTD2); u32x4* tokv = (u32x4*)(F.ws + WS_TOK); int* lists = (int*)(F.ws + WS_LIST);
    const float* brg = F.in[13]; const float* bre = F.in[15];
    float* sx1 = (float*)(F.ws + WS_SX1); unsigned char* X1Q = F.ws + WS_X1Q; const float* AMX = (const float*)(F.ws + WS_AMX);
    const int li = lane & 15, kq = lane >> 4;
    for (int grp = g0 + F.wave; grp < g1; grp += NWAVES) {
        const int tok0 = grp * 16;
        unsigned char* qrow = X1Q + (size_t)(tok0 + li) * 1024 + 8 * kq;
        const bf16_t* xr = X1 + (size_t)(tok0 + li) * 1024 + 8 * kq;
        const bf16_t* wr0 = Wr + (size_t)li * 1024 + 8 * kq;
        f32x4 acc[3];
#pragma unroll
        for (int t = 0; t < 3; ++t) acc[t] = (f32x4){0.f, 0.f, 0.f, 0.f};
        float mx; { const f32x4 am = *(const f32x4*)(AMX + (size_t)(tok0 + li) * 16 + 4 * kq); mx = fmaxf(fmaxf(am[0], am[1]), fmaxf(am[2], am[3])); }
        mx = fmaxf(mx, __shfl_xor(mx, 16)); mx = fmaxf(mx, __shfl_xor(mx, 32));
        const float amax = fmaxf(mx, 1e-30f), qs = 127.0f / amax;
#pragma unroll 4
        for (int kk = 0; kk < 32; ++kk) {
            const bf16x8 xa = *(const bf16x8*)(xr + 32 * kk);
            { const u32x4 xw = __builtin_bit_cast(u32x4, xa); unsigned q0 = 0u, q1 = 0u;
              q0 = __builtin_amdgcn_cvt_pk_u8_f32(rintf(bf_lo(xw[0]) * qs) + 128.0f, 0, q0); q0 = __builtin_amdgcn_cvt_pk_u8_f32(rintf(bf_hi(xw[0]) * qs) + 128.0f, 1, q0);
              q0 = __builtin_amdgcn_cvt_pk_u8_f32(rintf(bf_lo(xw[1]) * qs) + 128.0f, 2, q0); q0 = __builtin_amdgcn_cvt_pk_u8_f32(rintf(bf_hi(xw[1]) * qs) + 128.0f, 3, q0);
              q1 = __builtin_amdgcn_cvt_pk_u8_f32(rintf(bf_lo(xw[2]) * qs) + 128.0f, 0, q1); q1 = __builtin_amdgcn_cvt_pk_u8_f32(rintf(bf_hi(xw[2]) * qs) + 128.0f, 1, q1);
              q1 = __builtin_amdgcn_cvt_pk_u8_f32(rintf(bf_lo(xw[3]) * qs) + 128.0f, 2, q1); q1 = __builtin_amdgcn_cvt_pk_u8_f32(rintf(bf_hi(xw[3]) * qs) + 128.0f, 3, q1);
              *(u32x2*)(qrow + 32 * kk) = (u32x2){q0 ^ 0x80808080u, q1 ^ 0x80808080u}; }
#pragma unroll
            for (int t = 0; t < 3; ++t) { const bf16x8 wh = *(const bf16x8*)(wr0 + (size_t)16 * t * 1024 + 32 * kk), wl = *(const bf16x8*)(wr0 + (size_t)(48 + 16 * t) * 1024 + 32 * kk);
                acc[t] = __builtin_amdgcn_mfma_f32_16x16x32_bf16(xa, wh, acc[t], 0, 0, 0); acc[t] = __builtin_amdgcn_mfma_f32_16x16x32_bf16(xa, wl, acc[t], 0, 0, 0); }
        }
#pragma unroll
        for (int t = 0; t < 3; ++t)
#pragma unroll
            for (int r = 0; r < 4; ++r) scr[(4 * kq + r) * 48 + 16 * t + li] = acc[t][r];
        LDS_WAIT(); asm volatile("" ::: "memory");
        if (lane < 16) {
            const int tk = tok0 + lane; const float* sp = SSQ + (size_t)tk * 16; float ss = 0.f;
#pragma unroll
            for (int i = 0; i < 4; ++i) { const f32x4 q = *(const f32x4*)(sp + 4 * i); ss += (q[0] + q[1]) + (q[2] + q[3]); }
            const float rs = 1.0f / sqrtf(ss * (1.0f / 1024.0f) + EPS);
            rstd2[tk] = rs; sx1[tk] = amax * (1.0f / 127.0f);
            const LAS float* lg = scr + lane * 48;
            float gl[4]; float gm = -3.0e38f; int gi = 0;
#pragma unroll
            for (int j = 0; j < 4; ++j) { gl[j] = lg[j] * rs + brg[j]; if (gl[j] > gm) { gm = gl[j]; gi = j; } }
            float gz = 0.f;
#pragma unroll
            for (int j = 0; j < 4; ++j) gz += expf(gl[j] - gm);
            const float pg = 1.0f / gz;
            float el[8]; float m0 = -3.0e38f; int i0 = 0;
#pragma unroll
            for (int j = 0; j < 8; ++j) { el[j] = lg[4 + 8 * gi + j] * rs + bre[8 * gi + j]; if (el[j] > m0) { m0 = el[j]; i0 = j; } }
            float m1 = -3.0e38f; int i1 = 0;
#pragma unroll
            for (int j = 0; j < 8; ++j) { if (j != i0 && el[j] > m1) { m1 = el[j]; i1 = j; } }
            const float p1 = expf(m1 - m0);
            const float w0 = pg / (1.0f + p1), w1 = pg * p1 / (1.0f + p1);
            const int e0 = 8 * gi + i0, e1 = 8 * gi + i1;
            tokv[tk] = (u32x4){__float_as_uint(rs * amax * (1.0f / 127.0f)), (unsigned)(e0 | (e1 << 8)), __float_as_uint(w0), __float_as_uint(w1)};
            const unsigned pos0 = __hip_atomic_fetch_add((unsigned*)(F.ctl + CW_CNT + 64 * (2 * e0)), 1u, RLX_AGENT);
            lists[(size_t)(2 * e0) * LIST_CAP + pos0] = tk;
            const unsigned pos1 = __hip_atomic_fetch_add((unsigned*)(F.ctl + CW_CNT + 64 * (2 * e1 + 1)), 1u, RLX_AGENT);
            lists[(size_t)(2 * e1 + 1) * LIST_CAP + pos1] = tk;
            { const int a = i0 < i1 ? i0 : i1, b = i0 < i1 ? i1 : i0, pl = 28 * gi + (a * 8 - ((a * (a + 1)) >> 1)) + (b - a - 1);
              const unsigned pp = __hip_atomic_fetch_add((unsigned*)(F.ctl + CW_PCNT + 16 * pl), 1u, RLX_AGENT);
              ((unsigned*)(F.ws + WS_PLIST))[(size_t)pl * LIST_CAP + pp] = (unsigned)tk | (i0 > i1 ? 0x80000000u : 0u); }
        }
        LDS_WAIT(); asm volatile("" ::: "memory");
    }
}

__device__ __forceinline__ void quant_wgu(Frame& F) {
    quant_rows1024((const bf16_t*)(F.ws + WS_WGU), F.ws + WS_WGUQ, (float*)(F.ws + WS_SWGU), NEXP * 1024, F.vcu * NWAVES + F.wave, F.G * NWAVES);
}
#define MK_TID (F.wave * 64 + mk_lane())
#define MK_LEADER (F.wave == 0 && mk_lane() == 0)
struct Args { const float* in[19]; float* out; unsigned char* ws; };

__device__ __forceinline__ int wave_incl_scan(int v, int lane) {
#pragma unroll
    for (int o = 1; o < 64; o <<= 1) { const int t = __shfl_up(v, o); if (lane >= o) v += t; }
    return v;
}
__device__ __forceinline__ void moe_table(Frame& F, int nl, int lst0, int lstep) {
    LAS int* tab = (LAS int*)(F.lds + MOETAB_OFF);
    __syncthreads();
    if (F.wave == 0) { const int l = mk_lane();
        const int cnt = (int)__hip_atomic_load((unsigned*)(F.ctl + CW_CNT + 64 * l), RLX_AGENT); tab[80 + l] = cnt;
        const int li = lst0 + lstep * l; const int cj = (l < nl) ? __shfl(cnt, li & 63) : 0;
        const int t = (cj + 255) >> 8, s = wave_incl_scan(t, l);
        if (l < nl) tab[l] = s - t;
        if (l == 63) tab[nl] = s; }
    __syncthreads();
}

__device__ __forceinline__ void pair_table(Frame& F) {
    LAS int* tab = (LAS int*)(F.lds + MOETAB_OFF);
    __syncthreads();
    if (F.wave == 0) { const int l = mk_lane(); const bool v1 = (l + 64) < NPAIR;
        const int c0 = (int)__hip_atomic_load((unsigned*)(F.ctl + CW_PCNT + 16 * l), RLX_AGENT);
        const int c1 = v1 ? (int)__hip_atomic_load((unsigned*)(F.ctl + CW_PCNT + 16 * (l + 64)), RLX_AGENT) : 0;
        const int t0 = (c0 + 255) >> 8, t1 = (c1 + 255) >> 8;
        const int s0 = wave_incl_scan(t0, l), s1 = wave_incl_scan(t1, l), tot0 = __shfl(s0, 63), tot1 = __shfl(s1, 63);
        tab[l] = s0 - t0; tab[PairOrder::CNT0 + l] = c0;
        if (v1) { tab[64 + l] = tot0 + s1 - t1; tab[PairOrder::CNT0 + 64 + l] = c1; }
        if (l == 0) tab[NPAIR] = tot0 + tot1; }
    __syncthreads();
}

__global__ void __launch_bounds__(NWAVES * 64, 2) mk_fwd(Args args) {
    extern __shared__ __attribute__((aligned(16))) unsigned char lds[];
    Frame F;
    F.lds = (LAS unsigned char*)lds;
    F.MISC = (volatile LAS unsigned*)(F.lds + MISC_OFF);
    F.wave = __builtin_amdgcn_readfirstlane((int)threadIdx.x >> 6);

    F.G = gridDim.x; { const int bx = blockIdx.x; F.vcu = (F.G % 8 == 0) ? (bx % 8) * (F.G / 8) + bx / 8 : bx; }
    F.ws = args.ws; F.out = args.out; F.ctl = (gu32*)(args.ws + WS_CTL);
#pragma unroll
    for (int i = 0; i < 19; ++i) F.in[i] = args.in[i];
    for (int u = MK_TID; u < 2048 / 4; u += NWAVES * 64) ((LAS unsigned*)(F.lds + LDSCTL_OFF))[u] = 0u;
    __syncthreads();
    XcdBarrier bar = xcd_barrier_post((unsigned*)(F.ctl + CW_BAR), F.MISC + 8, MK_LEADER);
    unsigned char* ws = args.ws;
    const LAS int* tab = (const LAS int*)(F.lds + MOETAB_OFF);

    p0_prologue(F);
    xcd_barrier(bar, MK_LEADER);

    {
        DenseOrder S8; S8.T.init(MTOK / 256, 13, F.G, (int)blockIdx.x); S8.A = (const char*)(ws + WS_X0Q); S8.Bt = (const char*)(ws + WS_WINQ); S8.K = 512; S8.pn_split = 3; S8.pn_skip = 8;
        DenseOrder SQ; SQ.T.init(MTOK / 256, 8, F.G, (int)blockIdx.x); SQ.A = (const char*)(ws + WS_X0Q); SQ.Bt = (const char*)(ws + WS_WINQ); SQ.K = 512; SQ.pn_off = 3;
        { const u32x4* rsrc = (const u32x4*)(ws + WS_ROPE); LAS u32x4* rdst = (LAS u32x4*)(F.lds + ROPE_LDS_OFF); for (int i = MK_TID; i < 1024; i += NWAVES * 64) rdst[i] = rsrc[i];
          const u32x4* lsrc = (const u32x4*)(ws + WS_LBV); for (int i = MK_TID; i < 256; i += NWAVES * 64) rdst[1024 + i] = lsrc[i]; __syncthreads(); }
        EpiInProj<true, true> EQ; EQ.ws = ws; EQ.outb = (unsigned char*)F.out; EQ.ropeL = (const LAS f32x4*)(F.lds + ROPE_LDS_OFF);
        pg8::gemm_phase<EpiInProj<true, true>, DenseOrder, true, true>(F.lds + RING_OFF, F.wave, 512, SQ, EQ);
        __syncthreads();
        EpiInProj<true, false> E8; E8.ws = ws; E8.outb = (unsigned char*)F.out; E8.ropeL = (const LAS f32x4*)(F.lds + ROPE_LDS_OFF);
        pg8::gemm_phase<EpiInProj<true, false>, DenseOrder, true, true>(F.lds + RING_OFF, F.wave, 512, S8, E8);
    }
    xcd_barrier(bar, MK_LEADER);

    const float mbound = *(const float*)(ws + WS_QKN + 512);
    if (blockIdx.x < 32) {
        hg::hgrn_pair((int)blockIdx.x >> 2, (int)blockIdx.x & 3, F.lds + RING_OFF, ws, F.wave);
        __syncthreads();
        if (MK_LEADER) { __builtin_amdgcn_fence(__ATOMIC_RELEASE, "agent"); asm volatile("s_waitcnt vmcnt(0)" ::: "memory"); __hip_atomic_store((unsigned*)(F.ctl + CW_HFLAG + 64 * (int)blockIdx.x), 1u, RLX_AGENT); }
    }
    constexpr int NFIN = 256;
    const int myx = (int)(xb_xcc_id() & 7u);
    int vpre = -1; bool pf = false;
    for (;;) {
        __syncthreads();
        if (MK_TID == 0) {
            int code = -1; pf = false;
            unsigned v; if (vpre >= 0) { v = (unsigned)vpre; vpre = -1; } else v = __hip_atomic_fetch_add((unsigned*)(F.ctl + CW_QHEAD + 64 * myx), 1u, RLX_AGENT);
            if (v < 256u) { code = myx * 256 + (int)v; pf = v < 176u; }
            else {
                const unsigned f = __hip_atomic_fetch_add((unsigned*)(F.ctl + CW_QHEAD + 64 * 8), 1u, RLX_AGENT);
                if (f < (unsigned)NFIN) code = 2048 + (int)f;
                else for (int k = 1; k < 8 && code < 0; ++k) { const int y = (myx + k) & 7; v = __hip_atomic_fetch_add((unsigned*)(F.ctl + CW_QHEAD + 64 * y), 1u, RLX_AGENT); if (v < 256u) code = y * 256 + (int)v; }
            }
            F.MISC[12] = (unsigned)code;
        }
        __syncthreads();
        const int idx = (int)F.MISC[12];
        if (idx < 0) break;
        if (idx >= 2048) {
            const int f = idx - 2048, bh = f >> 3, sl = f & 7;
            if (F.wave == 0) {
                unsigned sp = 0; while (__builtin_amdgcn_readfirstlane((int)__hip_atomic_load((unsigned*)(F.ctl + CW_HFLAG + 64 * bh), RLX_AGENT)) == 0) { __builtin_amdgcn_s_sleep(8); if (++sp > (1u << 22)) break; }
                __builtin_amdgcn_fence(__ATOMIC_ACQUIRE, "agent"); asm volatile("s_waitcnt vmcnt(0)" ::: "memory");
            }
            __syncthreads();
            hgrn_finalize_bh(bh >> 2, bh & 3, sl * 1024, sl * 1024 + 1024, F.wave, ws);
            continue;
        }
        if (MK_TID == 0 && pf) vpre = (int)__hip_atomic_fetch_add((unsigned*)(F.ctl + CW_QHEAD + 64 * myx), 1u, RLX_AGENT);
        const int bkv = idx >> 7, r = idx & 127, b = bkv >> 1, hh = (bkv & 1) * 4 + (r >> 5), qb = r & 31;
        attn_body::attn_unit(b, hh, qb, (const attn_body::bf16*)(ws + WS_Q), (const attn_body::bf16*)(ws + WS_K), (const attn_body::bf16*)(ws + WS_V), (attn_body::bf16*)(ws + WS_Q), (char*)lds + RING_OFF, mbound, F.wave);
    }
    xcd_barrier(bar, MK_LEADER);
    {
        Seg2Order S; S.T.init(MTOK / 256, 4, F.G, (int)blockIdx.x); S.ws = (const char*)ws; S.K = 512;
        EpiMerge E; E.GAB = (const unsigned char*)F.out; E.MG = (bf16_t*)(ws + WS_MERGED);
        pg8::gemm_phase<EpiMerge, Seg2Order, true>(F.lds + RING_OFF, F.wave, 512, S, E);
    }
    xcd_barrier(bar, MK_LEADER);
    {
        DenseOrder S; S.T.init(MTOK / 256, 4, F.G, (int)blockIdx.x); S.A = (const char*)(ws + WS_MERGED); S.Bt = (const char*)(ws + WS_WOUT); S.K = 1024;
        EpiX1 E; E.X = F.in[0]; E.X1B = (bf16_t*)(ws + WS_X1B); E.SSQ = (float*)(ws + WS_SSQ); E.AMX = (float*)(ws + WS_AMX);
        pg8::gemm_phase<EpiX1, DenseOrder, true>(F.lds + RING_OFF, F.wave, 1024, S, E);
    }
    xcd_barrier(bar, MK_LEADER);
    for (int gb = F.vcu * 16; gb < MTOK / 16; gb += F.G * 16) router_phase(F, gb, gb + 16);
    quant_wgu(F);
    xcd_barrier(bar, MK_LEADER);
    moe_table(F, 64, 0, 1);
    {
        MoeOrder S; S.tab = tab; S.nl = 64; S.lst0 = 0; S.lstep = 1; S.lists = (const int*)(ws + WS_LIST); S.A = (const char*)(ws + WS_X1Q); S.W = (const char*)(ws + WS_WGUQ); S.wstride = (size_t)1024 * 1024; S.K = 512; S.G = F.G; S.c = F.vcu;
        EpiMoeUp E; E.tab = tab; E.lists = (const int*)(ws + WS_LIST); E.rstd2 = (const float*)(ws + WS_RSTD2); E.tok = (const u32x4*)(ws + WS_TOK); E.HID = (bf16_t*)(ws + WS_HID); E.SX1 = (const float*)(ws + WS_SX1); E.SWGU = (const float*)(ws + WS_SWGU);
        pg8::gemm_phase<EpiMoeUp, MoeOrder, true, true>(F.lds + RING_OFF, F.wave, 512, S, E);
    }
    xcd_barrier(bar, MK_LEADER);
    {
        pair_table(F);
        PairOrder S; S.tab = tab; S.plist = (const unsigned*)(ws + WS_PLIST); S.HID = (const char*)(ws + WS_HID); S.W = (const char*)(ws + WS_WD); S.wstride = (size_t)1024 * 512 * 2; S.K = 512; S.G = F.G; S.c = F.vcu;
        EpiMoeDown2 E; E.tab = tab; E.plist = (const unsigned*)(ws + WS_PLIST); E.OUT = F.out; E.X1B = (const bf16_t*)(ws + WS_X1B);
        pg8::gemm_phase<EpiMoeDown2, PairOrder, true>(F.lds + RING_OFF, F.wave, 512, S, E);
    }
}

extern "C" void kernel_launch(void* const* d_in, const int* in_sizes, int n_in, void* d_out, int out_size, void* d_ws, size_t ws_size, hipStream_t stream) {
    static int grid = 0;
    if (grid == 0) {
        if (n_in != 19 || out_size != MTOK * DMODEL || ws_size < WS_END) { fprintf(stderr, "kernel_launch: built for 19 inputs, %d outputs, >= %zu bytes of workspace; got n_in %d, out %d, ws %zu; nothing launched\n", MTOK * DMODEL, (size_t)WS_END, n_in, out_size, ws_size); grid = -1; return; }
        int dev = 0, cus = 0, per_cu = 0;
        if (hipGetDevice(&dev) != hipSuccess || hipDeviceGetAttribute(&cus, hipDeviceAttributeMultiprocessorCount, dev) != hipSuccess) { grid = -1; return; }
        if (hipFuncSetAttribute((const void*)mk_fwd, hipFuncAttributeMaxDynamicSharedMemorySize, LDS_BYTES) != hipSuccess) { fprintf(stderr, "kernel_launch: hipFuncSetAttribute failed\n"); grid = -1; return; }
        if (hipOccupancyMaxActiveBlocksPerMultiprocessor(&per_cu, (const void*)mk_fwd, NWAVES * 64, LDS_BYTES) != hipSuccess || per_cu < 1) fprintf(stderr, "kernel_launch: occupancy query reports %d workgroups per CU\n", per_cu);
        (void)hipGetLastError();
        grid = cus;
    }
    if (grid < 0) return;
    if (hipMemsetAsync((char*)d_ws + WS_CTL, 0, CTL_ZERO_BYTES, stream) != hipSuccess) return;
    Args a{};
    for (int i = 0; i < 19; ++i) a.in[i] = (const float*)d_in[i];
    a.out = (float*)d_out; a.ws = (unsigned char*)d_ws;
    hipLaunchKernelGGL(mk_fwd, dim3(grid), dim3(NWAVES * 64), LDS_BYTES, stream, a);
}
```
